# Optimizing an MI355X kernel written in HIP

```python
import math
import jax, jax.numpy as jnp
from jax import lax
import numpy as np

D_MODEL = 1024
BATCH = 4
SEQ = 4096
DEPTH = 4
DEC_BATCH = 4
DEC_SEQ = 8192
PAST_LEN = 128

CHUNK = 128
EPS = 1e-6
N_BRANCH = 3
BRANCH_DIM = 1024
SSD_HEADS = 16
SSD_HEAD_DIM = 64
SSD_DIM = SSD_HEADS * SSD_HEAD_DIM
SSD_GROUPS = 2
SSD_STATE = 128
SSD_CONV = 4
SSD_CONV_CH = SSD_DIM + 2 * SSD_GROUPS * SSD_STATE
ML_HEADS = 4
ML_QK = 128
ML_V = 256
ML_QK_DIM = ML_HEADS * ML_QK
ML_V_DIM = ML_HEADS * ML_V
RET_HEADS = 4
RET_QK = 128
RET_V = 256
RET_QK_DIM = RET_HEADS * RET_QK
RET_V_DIM = RET_HEADS * RET_V
ROPE_BASE = 10000.0
FFN_DIM = -(-8 * D_MODEL // (3 * 256)) * 256
IN_SIZES = (SSD_DIM, SSD_CONV_CH, 2 * SSD_HEADS,
            ML_QK_DIM, ML_QK_DIM, ML_V_DIM, ML_V_DIM, 4 * ML_HEADS,
            RET_QK_DIM, RET_QK_DIM, RET_V_DIM, RET_V_DIM)
IN_COLS = sum(IN_SIZES)

kernel_name = "hybrid_bidir_ssd_mlstm_retention_encoder"

F32 = jnp.float32


def split_cols(t, sizes):
    out, start = [], 0
    for n in sizes:
        out.append(t[..., start:start + n])
        start += n
    return out


def _flip(t):
    return jnp.flip(t, axis=1)


def rms_norm(x, g):
    xf = x.astype(F32)
    y = xf * lax.rsqrt(jnp.mean(xf * xf, axis=-1, keepdims=True) + EPS)
    return (y * g.astype(F32)).astype(x.dtype)


def head_rms_norm(y, g):
    y = y * lax.rsqrt(jnp.mean(y * y, axis=-1, keepdims=True) + EPS)
    return y.reshape(*y.shape[:-2], -1) * g.astype(F32)


def centred_conv(u, w, b):
    s = u.shape[1]
    left = SSD_CONV // 2
    right = SSD_CONV - 1 - left
    up = jnp.pad(u, ((0, 0), (left, right), (0, 0)))
    out = b
    for t in range(SSD_CONV):
        out = out + up[:, t:t + s] * w[t]
    return out


def rotary(t, pos):
    half = t.shape[-1] // 2
    inv = ROPE_BASE ** (-jnp.arange(half, dtype=F32) / half)
    ang = pos[:, None] * inv
    cos = jnp.cos(ang)[None, :, None, :]
    sin = jnp.sin(ang)[None, :, None, :]
    t1, t2 = t[..., :half], t[..., half:]
    return jnp.concatenate([t1 * cos - t2 * sin, t1 * sin + t2 * cos], axis=-1)


def ssd_scan(x, dt, a, bm, cm):
    bsz, s = x.shape[0], x.shape[1]
    nc = s // CHUNK
    e = SSD_HEADS // SSD_GROUPS
    x = x.reshape(bsz, nc, CHUNK, SSD_GROUPS, e, SSD_HEAD_DIM)
    dt = dt.reshape(bsz, nc, CHUNK, SSD_GROUPS, e)
    bm = bm.reshape(bsz, nc, CHUNK, SSD_GROUPS, SSD_STATE)
    cm = cm.reshape(bsz, nc, CHUNK, SSD_GROUPS, SSD_STATE)
    cs = jnp.cumsum(dt * a.reshape(SSD_GROUPS, e), axis=2)
    xdt = x * dt[..., None]
    tri = jnp.tril(jnp.ones((CHUNK, CHUNK), dtype=bool))[:, :, None, None]
    seg = cs[:, :, :, None] - cs[:, :, None, :]
    decay = jnp.exp(jnp.where(tri, seg, -jnp.inf))
    cb = jnp.einsum('bclgn,bcsgn->bclsg', cm, bm)
    y_diag = jnp.einsum('bclsge,bcsgep->bclgep', cb[..., None] * decay, xdt)
    to_end = jnp.exp(cs[:, :, -1:] - cs)
    states = jnp.einsum('bclgn,bclge,bclgep->bcgepn', bm, to_end, xdt)
    chunk_decay = jnp.exp(cs[:, :, -1])

    def step(h, inp):
        st, dec = inp
        return h * dec[..., None, None] + st, h

    h0 = jnp.zeros((bsz, SSD_GROUPS, e, SSD_HEAD_DIM, SSD_STATE), F32)
    _, prev = lax.scan(step, h0, (jnp.moveaxis(states, 1, 0), jnp.moveaxis(chunk_decay, 1, 0)))
    prev = jnp.moveaxis(prev, 0, 1)
    y_off = jnp.einsum('bclgn,bcgepn,bclge->bclgep', cm, prev, jnp.exp(cs))
    return (y_diag + y_off).reshape(bsz, s, SSD_HEADS, SSD_HEAD_DIM)


def ssd_mixer(z, xbc, dt_raw, conv_w, conv_b, a_log, dt_bias, d_skip, norm_g):
    dtype = z.dtype
    bsz, s = z.shape[0], z.shape[1]
    xbc = jax.nn.silu(centred_conv(xbc.astype(F32), conv_w.astype(F32), conv_b.astype(F32)))
    xs, bm, cm = split_cols(xbc, (SSD_DIM, SSD_GROUPS * SSD_STATE, SSD_GROUPS * SSD_STATE))
    xs = xs.reshape(bsz, s, SSD_HEADS, SSD_HEAD_DIM)
    bm = bm.reshape(bsz, s, SSD_GROUPS, SSD_STATE)
    cm = cm.reshape(bsz, s, SSD_GROUPS, SSD_STATE)
    dt = jax.nn.softplus(dt_raw.astype(F32).reshape(bsz, s, 2, SSD_HEADS) + dt_bias.astype(F32))
    a = -jnp.exp(a_log.astype(F32))
    y_f = ssd_scan(xs, dt[:, :, 0], a[0], bm, cm)
    y_b = _flip(ssd_scan(_flip(xs), _flip(dt[:, :, 1]), a[1], _flip(bm), _flip(cm)))
    y = y_f + y_b + xs * d_skip.astype(F32)[:, None]
    y = y.reshape(bsz, s, SSD_DIM) * jax.nn.silu(z.astype(F32))
    return rms_norm(y, norm_g).astype(dtype)


def mlstm_scan(q, k, v, i_pre, f_pre):
    bsz, s = q.shape[0], q.shape[1]
    nc = s // CHUNK

    def chunks(t):
        return jnp.moveaxis(t.reshape(bsz, nc, CHUNK, *t.shape[2:]), 1, 0)

    tri = jnp.tril(jnp.ones((CHUNK, CHUNK), dtype=bool))[None, :, :, None]

    def step(carry, inp):
        c_st, n_st, m_st = carry
        qq, kk, vv, ii, lf = inp
        bcum = jnp.cumsum(lf, axis=1)
        logd = jnp.where(tri, bcum[:, :, None] - bcum[:, None] + ii[:, None], -jnp.inf)
        inter = bcum + m_st[:, None]
        m_t = jnp.maximum(inter, jnp.max(logd, axis=2))
        w = jnp.exp(logd - m_t[:, :, None])
        w_inter = jnp.exp(inter - m_t)
        scores = jnp.einsum('bthd,bshd->btsh', qq, kk) * w
        num = (jnp.einsum('btsh,bshv->bthv', scores, vv)
               + w_inter[..., None] * jnp.einsum('bthd,bhdv->bthv', qq, c_st))
        den = jnp.sum(scores, axis=2) + w_inter * jnp.einsum('bthd,bhd->bth', qq, n_st)
        h = num / jnp.maximum(jnp.abs(den), jnp.exp(-m_t))[..., None]
        btot = bcum[:, -1]
        log_end = btot[:, None] - bcum + ii
        m_new = jnp.maximum(btot + m_st, jnp.max(log_end, axis=1))
        w_end = jnp.exp(log_end - m_new[:, None])
        dec = jnp.exp(btot + m_st - m_new)
        c_new = dec[..., None, None] * c_st + jnp.einsum('blh,blhd,blhv->bhdv', w_end, kk, vv)
        n_new = dec[..., None] * n_st + jnp.einsum('blh,blhd->bhd', w_end, kk)
        return (c_new, n_new, m_new), h

    carry0 = (jnp.zeros((bsz, ML_HEADS, ML_QK, ML_V), F32),
              jnp.zeros((bsz, ML_HEADS, ML_QK), F32),
              jnp.zeros((bsz, ML_HEADS), F32))
    xs = (chunks(q), chunks(k), chunks(v), chunks(i_pre), chunks(jax.nn.log_sigmoid(f_pre)))
    _, h = lax.scan(step, carry0, xs)
    return jnp.moveaxis(h, 0, 1).reshape(bsz, s, ML_HEADS, ML_V)


def mlstm_mixer(q, k, v, o, gates, gate_bias, norm_g):
    dtype = o.dtype
    bsz, s = q.shape[0], q.shape[1]
    q = q.astype(F32).reshape(bsz, s, ML_HEADS, ML_QK) * (ML_QK ** -0.5)
    k = k.astype(F32).reshape(bsz, s, ML_HEADS, ML_QK)
    v = v.astype(F32).reshape(bsz, s, ML_HEADS, ML_V)
    g = gates.astype(F32).reshape(bsz, s, 4, ML_HEADS) + gate_bias.astype(F32)
    h_f = mlstm_scan(q, k, v, g[:, :, 0], g[:, :, 1])
    h_b = _flip(mlstm_scan(_flip(q), _flip(k), _flip(v), _flip(g[:, :, 2]), _flip(g[:, :, 3])))
    h = head_rms_norm(h_f + h_b, norm_g)
    return (jax.nn.sigmoid(o.astype(F32)) * h).astype(dtype)


def retention_scan(q, k, v, log_gamma, include_diag):
    bsz, s = q.shape[0], q.shape[1]
    nc = s // CHUNK
    qc = q.reshape(bsz, nc, CHUNK, RET_HEADS, RET_QK)
    kc = k.reshape(bsz, nc, CHUNK, RET_HEADS, RET_QK)
    vc = v.reshape(bsz, nc, CHUNK, RET_HEADS, RET_V)
    pos = jnp.arange(CHUNK, dtype=F32)
    dist = pos[:, None] - pos[None, :]
    mask = (dist >= 0) if include_diag else (dist > 0)
    dmat = jnp.where(mask[:, :, None], jnp.exp(jnp.maximum(dist, 0.0)[:, :, None] * log_gamma), 0.0)
    scores = jnp.einsum('bclhd,bcshd->bclsh', qc, kc) * dmat
    y_intra = jnp.einsum('bclsh,bcshv->bclhv', scores, vc)
    zeta = jnp.exp((CHUNK - 1 - pos)[:, None] * log_gamma)
    xi = jnp.exp((pos + 1)[:, None] * log_gamma)
    states = jnp.einsum('bcshd,sh,bcshv->bchdv', kc, zeta, vc)
    chunk_decay = jnp.exp(CHUNK * log_gamma)

    def step(r, st):
        return r * chunk_decay[:, None, None] + st, r

    r0 = jnp.zeros((bsz, RET_HEADS, RET_QK, RET_V), F32)
    _, prev = lax.scan(step, r0, jnp.moveaxis(states, 1, 0))
    prev = jnp.moveaxis(prev, 0, 1)
    y_cross = jnp.einsum('bclhd,bchdv,lh->bclhv', qc, prev, xi)
    return (y_intra + y_cross).reshape(bsz, s, RET_HEADS, RET_V)


def retention_mixer(q, k, v, g, norm_g):
    dtype = g.dtype
    bsz, s = q.shape[0], q.shape[1]
    pos = jnp.arange(s, dtype=F32)
    q = rotary(q.astype(F32).reshape(bsz, s, RET_HEADS, RET_QK), pos)
    k = rotary(k.astype(F32).reshape(bsz, s, RET_HEADS, RET_QK), pos) * (RET_QK ** -0.5)
    v = v.astype(F32).reshape(bsz, s, RET_HEADS, RET_V)
    log_gamma = jnp.log(1.0 - jnp.exp(jnp.linspace(math.log(1.0 / 32.0), math.log(1.0 / 512.0), RET_HEADS, dtype=F32)))
    y = (retention_scan(q, k, v, log_gamma, True)
         + _flip(retention_scan(_flip(q), _flip(k), _flip(v), log_gamma, False)))
    y = head_rms_norm(y, norm_g)
    return (jax.nn.silu(g.astype(F32)) * y).astype(dtype)


def encoder_trunk(x, norm_mix_g, w_in, w_gate, b_gate, conv_w, conv_b, ssd_a_log, ssd_dt_bias,
                  ssd_d, ssd_norm_g, mlstm_gate_bias, mlstm_norm_g, ret_norm_g, w_branch, w_out,
                  norm_ffn_g, w_ffn_gate, w_ffn_up, w_ffn_down, final_norm_g):
    for layer in range(DEPTH):
        u = rms_norm(x, norm_mix_g[layer])
        (ssd_z, ssd_xbc, ssd_dt, ml_q, ml_k, ml_v, ml_o, ml_g,
         rt_q, rt_k, rt_v, rt_g) = split_cols(u @ w_in[layer], IN_SIZES)
        gate = jax.nn.sigmoid((u @ w_gate[layer] + b_gate[layer]).astype(F32))
        g_a, g_b, g_c = split_cols(gate, (D_MODEL, D_MODEL, D_MODEL))
        y_a = ssd_mixer(ssd_z, ssd_xbc, ssd_dt, conv_w[layer], conv_b[layer], ssd_a_log[layer],
                        ssd_dt_bias[layer], ssd_d[layer], ssd_norm_g[layer]) @ w_branch[layer, 0]
        y_b = mlstm_mixer(ml_q, ml_k, ml_v, ml_o, ml_g, mlstm_gate_bias[layer],
                          mlstm_norm_g[layer]) @ w_branch[layer, 1]
        y_c = retention_mixer(rt_q, rt_k, rt_v, rt_g, ret_norm_g[layer]) @ w_branch[layer, 2]
        merged = (g_a * y_a + g_b * y_b + g_c * y_c).astype(x.dtype)
        x = x + merged @ w_out[layer]
        h = rms_norm(x, norm_ffn_g[layer])
        x = x + (jax.nn.silu(h @ w_ffn_gate[layer]) * (h @ w_ffn_up[layer])) @ w_ffn_down[layer]
    return rms_norm(x, final_norm_g)


def setup_inputs(seed: int = 0) -> dict:
    key = jax.random.key(seed)
    ks = jax.random.split(key, 24)

    def nrm(k, shape, scale):
        return jax.random.normal(k, shape, F32) * scale

    x_prompt = nrm(ks[0], (BATCH, SEQ, D_MODEL), 1.0)
    x_sample = nrm(ks[1], (DEC_BATCH, DEC_SEQ, D_MODEL), 1.0)
    norm_mix_g = 1.0 + nrm(ks[2], (DEPTH, D_MODEL), 0.01)
    w_in = nrm(ks[3], (DEPTH, D_MODEL, IN_COLS), D_MODEL ** -0.5)
    w_gate = nrm(ks[4], (DEPTH, D_MODEL, N_BRANCH * D_MODEL), D_MODEL ** -0.5)
    b_gate = nrm(ks[5], (DEPTH, N_BRANCH * D_MODEL), 0.01)
    conv_w = nrm(ks[6], (DEPTH, SSD_CONV, SSD_CONV_CH), SSD_CONV ** -0.5)
    conv_b = nrm(ks[7], (DEPTH, SSD_CONV_CH), 0.01)
    ssd_a_log = jnp.log(jax.random.uniform(ks[8], (DEPTH, 2, SSD_HEADS), F32, 1.0, 16.0))
    dt0 = jnp.exp(jax.random.uniform(ks[9], (DEPTH, 2, SSD_HEADS), F32, math.log(1e-3), math.log(1e-1)))
    ssd_dt_bias = dt0 + jnp.log(-jnp.expm1(-dt0))
    ssd_d = 1.0 + nrm(ks[10], (DEPTH, SSD_HEADS), 0.1)
    ssd_norm_g = 1.0 + nrm(ks[11], (DEPTH, SSD_DIM), 0.01)
    f_base = jnp.linspace(3.0, 6.0, ML_HEADS, dtype=F32)
    gate_base = jnp.stack([jnp.zeros_like(f_base), f_base, jnp.zeros_like(f_base), f_base])
    mlstm_gate_bias = gate_base + nrm(ks[12], (DEPTH, 4, ML_HEADS), 0.1)
    mlstm_norm_g = 1.0 + nrm(ks[13], (DEPTH, ML_V_DIM), 0.01)
    ret_norm_g = 1.0 + nrm(ks[14], (DEPTH, RET_V_DIM), 0.01)
    w_branch = nrm(ks[15], (DEPTH, N_BRANCH, BRANCH_DIM, D_MODEL), BRANCH_DIM ** -0.5)
    w_out = nrm(ks[16], (DEPTH, D_MODEL, D_MODEL), D_MODEL ** -0.5)
    norm_ffn_g = 1.0 + nrm(ks[17], (DEPTH, D_MODEL), 0.01)
    w_ffn_gate = nrm(ks[18], (DEPTH, D_MODEL, FFN_DIM), D_MODEL ** -0.5)
    w_ffn_up = nrm(ks[19], (DEPTH, D_MODEL, FFN_DIM), D_MODEL ** -0.5)
    w_ffn_down = nrm(ks[20], (DEPTH, FFN_DIM, D_MODEL), FFN_DIM ** -0.5)
    final_norm_g = 1.0 + nrm(ks[21], (D_MODEL,), 0.01)
    return {"x_prompt": x_prompt, "x_sample": x_sample, "norm_mix_g": norm_mix_g, "w_in": w_in,
            "w_gate": w_gate, "b_gate": b_gate, "conv_w": conv_w, "conv_b": conv_b,
            "ssd_a_log": ssd_a_log, "ssd_dt_bias": ssd_dt_bias, "ssd_d": ssd_d,
            "ssd_norm_g": ssd_norm_g, "mlstm_gate_bias": mlstm_gate_bias,
            "mlstm_norm_g": mlstm_norm_g, "ret_norm_g": ret_norm_g, "w_branch": w_branch,
            "w_out": w_out, "norm_ffn_g": norm_ffn_g, "w_ffn_gate": w_ffn_gate,
            "w_ffn_up": w_ffn_up, "w_ffn_down": w_ffn_down, "final_norm_g": final_norm_g}


def reference(x_prompt, x_sample, norm_mix_g, w_in, w_gate, b_gate, conv_w, conv_b, ssd_a_log,
              ssd_dt_bias, ssd_d, ssd_norm_g, mlstm_gate_bias, mlstm_norm_g, ret_norm_g, w_branch,
              w_out, norm_ffn_g, w_ffn_gate, w_ffn_up, w_ffn_down, final_norm_g):
    y_prompt = encoder_trunk(x_prompt, norm_mix_g, w_in, w_gate, b_gate, conv_w, conv_b, ssd_a_log,
                             ssd_dt_bias, ssd_d, ssd_norm_g, mlstm_gate_bias, mlstm_norm_g, ret_norm_g,
                             w_branch, w_out, norm_ffn_g, w_ffn_gate, w_ffn_up, w_ffn_down, final_norm_g)
    y_sample = encoder_trunk(x_sample, norm_mix_g, w_in, w_gate, b_gate, conv_w, conv_b, ssd_a_log,
                             ssd_dt_bias, ssd_d, ssd_norm_g, mlstm_gate_bias, mlstm_norm_g, ret_norm_g,
                             w_branch, w_out, norm_ffn_g, w_ffn_gate, w_ffn_up, w_ffn_down, final_norm_g)
    return (y_prompt, y_sample)
```

```cpp
#include <hip/hip_runtime.h>
#include <hip/hip_cooperative_groups.h>
#include <cstdio>
namespace cg = cooperative_groups;
#define LAS __attribute__((address_space(3)))
typedef unsigned short bf16_t;
typedef short bf16x8 __attribute__((ext_vector_type(8)));
typedef float f32x4 __attribute__((ext_vector_type(4)));
typedef float f32x16 __attribute__((ext_vector_type(16)));
typedef unsigned u32x4 __attribute__((ext_vector_type(4)));
typedef unsigned u32x2 __attribute__((ext_vector_type(2)));

constexpr int D = 1024, T = 16384, FF = 2816, NPROJ = 8752, PLD = 8960;
constexpr int C_Z = 0, C_XBC = 1024, C_DT = 2560, C_MLQ = 2592, C_MLK = 3104, C_MLV = 3616, C_MLO = 4640, C_MLG = 5664,
              C_RTQ = 5680, C_RTK = 6192, C_RTV = 6704, C_RTG = 7728;
constexpr float EPS = 1e-6f;

constexpr size_t WS_W1 = 0;
constexpr size_t WS_WG = WS_W1 + (size_t)PLD * 1024 * 2;
constexpr size_t WS_W2 = WS_WG + (size_t)3072 * 1024 * 2;
constexpr size_t WS_W3 = WS_W2 + (size_t)3072 * 1024 * 2;
constexpr size_t WS_W4 = WS_W3 + (size_t)1024 * 3072 * 2;
constexpr size_t WS_W5 = WS_W4 + (size_t)5632 * 1024 * 2;
constexpr size_t WS_XB = WS_W5 + (size_t)1024 * FF * 2;
constexpr size_t WS_SSQ = WS_XB + (size_t)T * 1024 * 2;
constexpr size_t WS_GS = WS_SSQ + (size_t)T * 16 * 4;
constexpr size_t WS_PROJ = WS_GS + (size_t)T * 48 * 4;
constexpr size_t WS_XC = WS_PROJ + (size_t)T * PLD * 2;
constexpr size_t WS_YF = WS_XC + (size_t)T * 1536 * 2;
constexpr size_t WS_YB = WS_YF + (size_t)T * 3072 * 2;
constexpr size_t WS_ACT = WS_YB + (size_t)T * 3072 * 2;
constexpr size_t WS_END = WS_ACT + (size_t)T * 3072 * 2;
constexpr size_t WS_HID = WS_PROJ;
constexpr size_t WS_GATE = WS_ACT;
constexpr int ACT_COL = 1024;
constexpr size_t WS_GATED = WS_YF;
constexpr size_t WS_BAR = WS_END;
constexpr size_t WS_WB = WS_END + 16384;
constexpr size_t WS_DEN = WS_WB + WS_XB;
constexpr size_t WS_TOTAL = WS_DEN + (size_t)2 * 4 * T * 2 * 4;

struct Params {
  const float* in[22];
  float* out;
  unsigned char* ws;
};

__device__ __forceinline__ int opaque_tid() { int t = threadIdx.x; asm volatile("" : "+v"(t)); return t; }
typedef __bf16 bf16x2_t __attribute__((ext_vector_type(2)));
typedef float f32x2_t __attribute__((ext_vector_type(2)));
__device__ __forceinline__ unsigned cvt_pk_bf16(float lo, float hi) { const f32x2_t v = {lo, hi}; const bf16x2_t b = __builtin_convertvector(v, bf16x2_t); return __builtin_bit_cast(unsigned, b); }
__device__ __forceinline__ bf16_t f2bf(float f) { return (bf16_t)(cvt_pk_bf16(f, 0.f) & 0xffffu); }
__device__ __forceinline__ float bf2f(bf16_t b) { return __uint_as_float(((unsigned)b) << 16); }
__device__ __forceinline__ float bflo(unsigned w) { return __uint_as_float(w << 16); }
__device__ __forceinline__ float bfhi(unsigned w) { return __uint_as_float(w & 0xffff0000u); }
__device__ __forceinline__ float sigmoidf_(float x) { return __builtin_amdgcn_rcpf(1.f + __expf(-x)); }
__device__ __forceinline__ float siluf_(float x) { return x * __builtin_amdgcn_rcpf(1.f + __expf(-x)); }
__device__ __forceinline__ float softplusf_(float x) {
  const float e = __expf(fminf(x, 20.f));
  const float sp = e < 2e-3f ? e * (1.f - 0.5f * e + 0.33333334f * e * e) : __logf(1.f + e);
  return x > 20.f ? x : sp;
}

namespace pg8 {
constexpr int BM = 256, BK = 64, HALF = 128, HTB = HALF * BK * 2, STAGE_BYTES = 8 * HTB, NXCD = 8, WGM = 8;
__host__ __device__ __forceinline__ int lds_byte(int r, int c) { const int st = (r >> 4) * 2 + (c >> 5), rr = r & 15, cc = c & 31, ob = rr * 64 + cc * 2; return st * 1024 + (ob ^ (((ob >> 9) & 1) << 5)); }
__host__ __device__ __forceinline__ void stage_rc(int b, int& R, int& C) { const int st = b / 1024, sb = b % 1024, swz = sb ^ (((sb >> 9) & 1) << 5); R = (st >> 1) * 16 + swz / 64; C = (st & 1) * 32 + (swz % 64) / 2; }
__host__ __device__ __forceinline__ int perm32(int rho) { const int n = rho >> 4, i = rho & 15; return 8 * (i >> 2) + 4 * n + (i & 3); }
struct Unit { int pm, pn; };
struct Gemm { const bf16_t* A; const bf16_t* Bt; int M, N, K, lda; int asel_div; int asel_stride; };
struct StaticOrder {
    int nM, nN, nwg, G, c;
    __device__ void init(int M, int N, int G_, int c_) { nM = M / BM; nN = N / BM; nwg = nM * nN; G = G_; c = c_; }
    __device__ bool next(int i, Unit& u) const {
        const long L = (long)i * G + c; if (L >= nwg) return false;
        int wgid = (int)L; { const int q = nwg / NXCD, r = nwg % NXCD, xcd = wgid % NXCD, off = wgid / NXCD; wgid = (xcd < r ? xcd * (q + 1) : r * (q + 1) + (xcd - r) * q) + off; }
        const int nig = WGM * nN, gid = wgid / nig, fm = gid * WGM, gsz = (nM - fm) < WGM ? (nM - fm) : WGM;
        u.pm = fm + ((wgid % nig) % gsz); u.pn = (wgid % nig) / gsz; return true;
    }
};

struct BranchOrder {
    StaticOrder so;
    __device__ void init(int M, int G_, int c_) { so.init(M, 1024, G_, c_); }
    __device__ bool next(int i, Unit& u) const { Unit t; const int q = i / 3; if (!so.next(q, t)) return false; u.pm = t.pm; u.pn = (i - 3 * q) * 4 + t.pn; return true; }
};
template <class Epi, class Sched>
__device__ __forceinline__ void gemm_phase(LAS unsigned char* lds, const Gemm g, const Sched& S, const Epi& E) {
    const int tid = opaque_tid(), wid = __builtin_amdgcn_readfirstlane(tid >> 6), lane = tid & 63, wr = wid >> 2, wc = wid & 3, fr = lane & 15, fq = lane >> 4;
    const int K = g.K, nt = K / BK;
    unsigned voffA[2], voffB[2];
#pragma unroll
    for (int i = 0; i < 2; ++i) { int R, C; stage_rc(tid * 16 + i * 8192, R, C); const int Rb = Epi::PERM ? ((R & ~31) + perm32(R & 31)) : R;
        voffA[i] = (unsigned)(R * g.lda + C) * 2u; voffB[i] = (unsigned)(Rb * K + C) * 2u; }
    const size_t kstep = (size_t)(BK * 2);
    const size_t hstepA = (size_t)HALF * g.lda * 2, tstepA = 2 * hstepA;
    const size_t hstepB = (size_t)HALF * K * 2, tstepB = 2 * hstepB;
    const unsigned ldsw = (unsigned)wid * 1024u;
    const int aoff = lds_byte(wr * 64 + fr, fq * 8), boff = lds_byte(wc * 32 + fr, fq * 8);
#define PG8_SA(b, h) (((b) * 2 + (h)) * HTB)
#define PG8_SB(b, h) ((4 + (b) * 2 + (h)) * HTB)
#define PG8_STAGE(bufoff, gbase, voff) do { _Pragma("unroll") for (int _i = 0; _i < 2; ++_i) \
        __builtin_amdgcn_global_load_lds((const unsigned*)((const char*)(gbase) + (voff)[_i]), (LAS unsigned*)(lds + (bufoff) + ldsw + _i * 8192), 16, 0, 0); } while (0)
#define PG8_LDA(dst, b, h) do { _Pragma("unroll") for (int m = 0; m < 4; ++m) _Pragma("unroll") for (int k = 0; k < 2; ++k) dst[m][k] = *(const LAS bf16x8*)(lds + PG8_SA(b, h) + aoff + m * 2048 + k * 1024); } while (0)
#define PG8_LDB(dst, b, h) do { _Pragma("unroll") for (int n = 0; n < 2; ++n) _Pragma("unroll") for (int k = 0; k < 2; ++k) dst[n][k] = *(const LAS bf16x8*)(lds + PG8_SB(b, h) + boff + n * 2048 + k * 1024); } while (0)
#define PG8_MMA(ai, bj, At, Bt) do { __builtin_amdgcn_s_setprio(1); _Pragma("unroll") for (int m = 0; m < 4; ++m) _Pragma("unroll") for (int n = 0; n < 2; ++n) _Pragma("unroll") for (int k = 0; k < 2; ++k) \
        acc[ai][bj][m][n] = __builtin_amdgcn_mfma_f32_16x16x32_bf16(Bt[n][k], At[m][k], acc[ai][bj][m][n], 0, 0, 0); __builtin_amdgcn_s_setprio(0); } while (0)
#define PG8_WAIT_V(n) asm volatile("s_waitcnt vmcnt(" #n ")" ::: "memory")
#define PG8_WAIT_L(n) asm volatile("s_waitcnt lgkmcnt(" #n ")" ::: "memory")
#define PG8_BAR __builtin_amdgcn_s_barrier()
#define PG8_SCHED __builtin_amdgcn_sched_barrier(0)
    Unit cur, nxt; int ui = 0;
    if (!S.next(0, cur)) return;
    f32x4 acc[2][2][4][2];
#pragma unroll
    for (int a = 0; a < 2; ++a)
#pragma unroll
        for (int b = 0; b < 2; ++b)
#pragma unroll
            for (int m = 0; m < 4; ++m)
#pragma unroll
                for (int n = 0; n < 2; ++n) acc[a][b][m][n] = (f32x4){0.f, 0.f, 0.f, 0.f};
    bf16x8 At[4][2], B0[2][2], B1[2][2];
    const char* cA = (const char*)g.A + (size_t)(cur.pn / g.asel_div) * g.asel_stride * 2 + (size_t)cur.pm * tstepA; const char* cB = (const char*)g.Bt + (size_t)cur.pn * tstepB;
    PG8_STAGE(PG8_SB(0, 0), cB, voffB); PG8_STAGE(PG8_SA(0, 0), cA, voffA); PG8_STAGE(PG8_SB(0, 1), cB + hstepB, voffB); PG8_STAGE(PG8_SA(0, 1), cA + hstepA, voffA);
    if (wr == 1) PG8_BAR;
    PG8_WAIT_V(4); PG8_BAR;
    PG8_STAGE(PG8_SB(1, 0), cB + kstep, voffB); PG8_STAGE(PG8_SA(1, 0), cA + kstep, voffA); PG8_STAGE(PG8_SB(1, 1), cB + hstepB + kstep, voffB);
    PG8_WAIT_V(6); PG8_BAR;
    for (;;) {
        const bool has_next = S.next(ui + 1, nxt);
        const char* nA = has_next ? (const char*)g.A + (size_t)(nxt.pn / g.asel_div) * g.asel_stride * 2 + (size_t)nxt.pm * tstepA : cA; const char* nB = has_next ? (const char*)g.Bt + (size_t)nxt.pn * tstepB : cB;
        for (int t = 0; t < nt; t += 2) {
            const bool last = (t == nt - 2);
            const char* a1 = cA + (size_t)(t + 1) * kstep;
            const char* a2 = last ? nA : cA + (size_t)(t + 2) * kstep; const char* b2 = last ? nB : cB + (size_t)(t + 2) * kstep;
            const char* a3 = a2 + kstep; const char* b3 = b2 + kstep;
            PG8_LDB(B0, 0, 0); PG8_SCHED; PG8_LDA(At, 0, 0); PG8_STAGE(PG8_SA(1, 1), a1 + hstepA, voffA);
            PG8_WAIT_L(8); PG8_BAR; PG8_WAIT_L(0); PG8_MMA(0, 0, At, B0); PG8_BAR; PG8_SCHED;
            PG8_LDB(B1, 0, 1); PG8_STAGE(PG8_SB(0, 0), b2, voffB);
            PG8_BAR; PG8_WAIT_L(0); PG8_MMA(0, 1, At, B1); PG8_BAR;
            PG8_LDA(At, 0, 1); PG8_STAGE(PG8_SA(0, 0), a2, voffA);
            PG8_BAR; PG8_WAIT_L(0); PG8_MMA(1, 0, At, B0); PG8_BAR; PG8_SCHED;
            PG8_STAGE(PG8_SB(0, 1), b2 + hstepB, voffB);
            PG8_WAIT_V(6); PG8_BAR; PG8_MMA(1, 1, At, B1); PG8_BAR;
            PG8_LDB(B0, 1, 0); PG8_SCHED; PG8_LDA(At, 1, 0); PG8_STAGE(PG8_SA(0, 1), a2 + hstepA, voffA);
            PG8_WAIT_L(8); PG8_BAR; PG8_WAIT_L(0); PG8_MMA(0, 0, At, B0); PG8_BAR; PG8_SCHED;
            PG8_LDB(B1, 1, 1); PG8_STAGE(PG8_SB(1, 0), b3, voffB);
            PG8_BAR; PG8_WAIT_L(0); PG8_MMA(0, 1, At, B1); PG8_BAR;
            PG8_LDA(At, 1, 1); PG8_STAGE(PG8_SA(1, 0), a3, voffA);
            PG8_BAR; PG8_WAIT_L(0); PG8_MMA(1, 0, At, B0); PG8_BAR; PG8_SCHED;
            PG8_STAGE(PG8_SB(1, 1), b3 + hstepB, voffB);
            PG8_WAIT_V(6); PG8_BAR; PG8_MMA(1, 1, At, B1); PG8_BAR;
        }
        E(acc, cur, wr, wc, fr, fq);
        if (!has_next) break;
#pragma unroll
        for (int a = 0; a < 2; ++a)
#pragma unroll
            for (int b = 0; b < 2; ++b)
#pragma unroll
                for (int m = 0; m < 4; ++m)
#pragma unroll
                    for (int n = 0; n < 2; ++n) acc[a][b][m][n] = (f32x4){0.f, 0.f, 0.f, 0.f};
        cur = nxt; cA = nA; cB = nB; ++ui;
    }
    PG8_WAIT_V(0);
    if (wr == 0) PG8_BAR;
    PG8_BAR;
#undef PG8_SA
#undef PG8_SB
#undef PG8_STAGE
#undef PG8_LDA
#undef PG8_LDB
#undef PG8_MMA
#undef PG8_WAIT_V
#undef PG8_WAIT_L
#undef PG8_BAR
#undef PG8_SCHED
}
}
using pg8::Unit;

__device__ __forceinline__ float row_rstd(const float* ssq, int row) {
  const f32x4 a = *(const f32x4*)(ssq + (size_t)row * 4) + *(const f32x4*)(ssq + (size_t)(T + row) * 4) + *(const f32x4*)(ssq + (size_t)(2 * T + row) * 4) + *(const f32x4*)(ssq + (size_t)(3 * T + row) * 4);
  return rsqrtf((a[0] + a[1] + a[2] + a[3]) * (1.0f / 1024.0f) + EPS);
}

struct EpiProj {
  static constexpr bool PERM = true;
  bf16_t* proj; float* gs; const float* ssq;
  __device__ __forceinline__ void operator()(const f32x4 (&acc)[2][2][4][2], const Unit& u, int wr, int wc, int fr, int fq) const {
    const int row0 = u.pm * 256 + wr * 64 + fr, col0 = u.pn * 256 + wc * 32 + 8 * fq;
#pragma unroll
    for (int ai = 0; ai < 2; ++ai) {
      float rs[4];
#pragma unroll
      for (int m = 0; m < 4; ++m) rs[m] = row_rstd(ssq, row0 + ai * 128 + m * 16);
#pragma unroll
      for (int m = 0; m < 4; ++m) {
        const int row = row0 + ai * 128 + m * 16;
#pragma unroll
        for (int bj = 0; bj < 2; ++bj) {
          const int c = col0 + bj * 128;
          f32x4 v0 = acc[ai][bj][m][0] * rs[m], v1 = acc[ai][bj][m][1] * rs[m];
          if (c < NPROJ) { u32x4 w; w.x = cvt_pk_bf16(v0[0], v0[1]); w.y = cvt_pk_bf16(v0[2], v0[3]); w.z = cvt_pk_bf16(v1[0], v1[1]); w.w = cvt_pk_bf16(v1[2], v1[3]);
            *(u32x4*)(proj + (size_t)row * PLD + c) = w; }
          if (c >= C_DT && c < C_DT + 32) { float* q = gs + (size_t)row * 32 + (c - C_DT); *(f32x4*)q = v0; *(f32x4*)(q + 4) = v1; }
          if (c >= C_MLG && c < C_MLG + 16) { float* q = gs + (size_t)T * 32 + (size_t)row * 16 + (c - C_MLG); *(f32x4*)q = v0; *(f32x4*)(q + 4) = v1; }
        }
      }
    }
  }
};
struct EpiGate {
  static constexpr bool PERM = true;
  bf16_t* gate; const float* bias; const float* ssq;
  __device__ __forceinline__ void operator()(const f32x4 (&acc)[2][2][4][2], const Unit& u, int wr, int wc, int fr, int fq) const {
    const int row0 = u.pm * 256 + wr * 64 + fr, col0 = u.pn * 256 + wc * 32 + 8 * fq;
    float rs[2][4]; f32x4 bv[2][2];
#pragma unroll
    for (int bj = 0; bj < 2; ++bj) { bv[bj][0] = *(const f32x4*)(bias + col0 + bj * 128); bv[bj][1] = *(const f32x4*)(bias + col0 + bj * 128 + 4); }
#pragma unroll
    for (int ai = 0; ai < 2; ++ai)
#pragma unroll
      for (int m = 0; m < 4; ++m) rs[ai][m] = row_rstd(ssq, row0 + ai * 128 + m * 16);
#pragma unroll
    for (int ai = 0; ai < 2; ++ai)
#pragma unroll
      for (int m = 0; m < 4; ++m) {
        const int row = row0 + ai * 128 + m * 16;
#pragma unroll
        for (int bj = 0; bj < 2; ++bj) {
          const int c = col0 + bj * 128;
          f32x4 v0 = acc[ai][bj][m][0] * rs[ai][m] + bv[bj][0], v1 = acc[ai][bj][m][1] * rs[ai][m] + bv[bj][1];
#pragma unroll
          for (int j = 0; j < 4; ++j) { v0[j] = sigmoidf_(v0[j]); v1[j] = sigmoidf_(v1[j]); }
          u32x4 w; w.x = cvt_pk_bf16(v0[0], v0[1]); w.y = cvt_pk_bf16(v0[2], v0[3]); w.z = cvt_pk_bf16(v1[0], v1[1]); w.w = cvt_pk_bf16(v1[2], v1[3]);
          *(u32x4*)(gate + (size_t)row * 3072 + c) = w;
        }
      }
  }
};
struct EpiBranch {
  static constexpr bool PERM = true;
  const bf16_t* gate; bf16_t* merged;
  __device__ __forceinline__ void operator()(const f32x4 (&acc)[2][2][4][2], const Unit& u, int wr, int wc, int fr, int fq) const {
    const int br = u.pn >> 2;
    const int row0 = u.pm * 256 + wr * 64 + fr, col0 = u.pn * 256 + wc * 32 + 8 * fq, mcol0 = (u.pn & 3) * 256 + wc * 32 + 8 * fq;
#pragma unroll
    for (int ai = 0; ai < 2; ++ai) {
      u32x4 gw[4][2], mw[4][2];
#pragma unroll
      for (int m = 0; m < 4; ++m)
#pragma unroll
        for (int bj = 0; bj < 2; ++bj) {
          gw[m][bj] = *(const u32x4*)(gate + (size_t)(row0 + ai * 128 + m * 16) * 3072 + col0 + bj * 128);
          mw[m][bj] = br ? *(const u32x4*)(merged + (size_t)(row0 + ai * 128 + m * 16) * 1024 + mcol0 + bj * 128) : (u32x4){0u, 0u, 0u, 0u};
        }
#pragma unroll
      for (int m = 0; m < 4; ++m) {
        const int row = row0 + ai * 128 + m * 16;
#pragma unroll
        for (int bj = 0; bj < 2; ++bj) {
          const u32x4 g = gw[m][bj], o = mw[m][bj];
          const f32x4 a0 = acc[ai][bj][m][0], a1 = acc[ai][bj][m][1];
          u32x4 w;
          w.x = cvt_pk_bf16(a0[0] * bflo(g.x) + bflo(o.x), a0[1] * bfhi(g.x) + bfhi(o.x)); w.y = cvt_pk_bf16(a0[2] * bflo(g.y) + bflo(o.y), a0[3] * bfhi(g.y) + bfhi(o.y));
          w.z = cvt_pk_bf16(a1[0] * bflo(g.z) + bflo(o.z), a1[1] * bfhi(g.z) + bfhi(o.z)); w.w = cvt_pk_bf16(a1[2] * bflo(g.w) + bflo(o.w), a1[3] * bfhi(g.w) + bfhi(o.w));
          *(u32x4*)(merged + (size_t)row * 1024 + mcol0 + bj * 128) = w;
        }
      }
    }
  }
};
struct EpiRes {
  static constexpr bool PERM = false;
  bf16_t* xb; float* ssq;
  __device__ __forceinline__ void operator()(const f32x4 (&acc)[2][2][4][2], const Unit& u, int wr, int wc, int fr, int fq) const {
    const int row0 = u.pm * 256 + wr * 64 + fr, col0 = u.pn * 256 + wc * 32 + 4 * fq;
    u32x2 xw[2][4][2][2];
#pragma unroll
    for (int ai = 0; ai < 2; ++ai)
#pragma unroll
      for (int m = 0; m < 4; ++m)
#pragma unroll
        for (int bj = 0; bj < 2; ++bj)
#pragma unroll
          for (int n = 0; n < 2; ++n) xw[ai][m][bj][n] = *(const u32x2*)(xb + (size_t)(row0 + ai * 128 + m * 16) * 1024 + col0 + bj * 128 + n * 16);
#pragma unroll
    for (int ai = 0; ai < 2; ++ai)
#pragma unroll
      for (int m = 0; m < 4; ++m) {
        const int row = row0 + ai * 128 + m * 16; float sq = 0.f;
#pragma unroll
        for (int bj = 0; bj < 2; ++bj)
#pragma unroll
          for (int n = 0; n < 2; ++n) {
            const size_t off = (size_t)row * 1024 + col0 + bj * 128 + n * 16;
            const u32x2 o = xw[ai][m][bj][n];
            f32x4 v = acc[ai][bj][m][n];
            v[0] += bflo(o.x); v[1] += bfhi(o.x); v[2] += bflo(o.y); v[3] += bfhi(o.y);
            u32x2 w; w.x = cvt_pk_bf16(v[0], v[1]); w.y = cvt_pk_bf16(v[2], v[3]);
            *(u32x2*)(xb + off) = w;
            sq += (v[0] * v[0] + v[1] * v[1]) + (v[2] * v[2] + v[3] * v[3]);
          }
        sq += __shfl_xor(sq, 16); sq += __shfl_xor(sq, 32);
        if (fq == 0) ssq[((size_t)u.pn * T + row) * 4 + wc] = sq;
      }
  }
};
struct EpiFfn {
  static constexpr bool PERM = true;
  bf16_t* hid; const float* ssq;
  __device__ __forceinline__ void operator()(const f32x4 (&acc)[2][2][4][2], const Unit& u, int wr, int wc, int fr, int fq) const {
    const int row0 = u.pm * 256 + wr * 64 + fr, hc = u.pn * 128 + wc * 32 + 8 * fq;
    float rs[2][4];
#pragma unroll
    for (int ai = 0; ai < 2; ++ai)
#pragma unroll
      for (int m = 0; m < 4; ++m) rs[ai][m] = row_rstd(ssq, row0 + ai * 128 + m * 16);
#pragma unroll
    for (int ai = 0; ai < 2; ++ai)
#pragma unroll
      for (int m = 0; m < 4; ++m) {
        const int row = row0 + ai * 128 + m * 16; const float r = rs[ai][m];
        f32x4 o0, o1;
#pragma unroll
        for (int j = 0; j < 4; ++j) {
          o0[j] = siluf_(acc[ai][0][m][0][j] * r) * (acc[ai][1][m][0][j] * r);
          o1[j] = siluf_(acc[ai][0][m][1][j] * r) * (acc[ai][1][m][1][j] * r);
        }
        u32x4 w; w.x = cvt_pk_bf16(o0[0], o0[1]); w.y = cvt_pk_bf16(o0[2], o0[3]); w.z = cvt_pk_bf16(o1[0], o1[1]); w.w = cvt_pk_bf16(o1[2], o1[3]);
        *(u32x4*)(hid + (size_t)row * FF + hc) = w;
      }
  }
};

__device__ __forceinline__ void cvt_tile(LAS float* tl, const float* src, int sld, int k0, int n0, int nvalid, const float* scale,
                                         bf16_t* dst, int dld, int r0, int c0, int ncopy) {
  const int tid = opaque_tid();
#pragma unroll
  for (int it = 0; it < 2; ++it) {
    const int k = (tid >> 4) + it * 32, n4 = (tid & 15) * 4;
    f32x4 v = (f32x4){0.f, 0.f, 0.f, 0.f};
    if (n0 + n4 < nvalid) v = __builtin_nontemporal_load((const f32x4*)(src + (size_t)(k0 + k) * sld + n0 + n4));
    const float s = scale ? scale[k0 + k] : 1.f;
    tl[k * 65 + n4 + 0] = v[0] * s; tl[k * 65 + n4 + 1] = v[1] * s; tl[k * 65 + n4 + 2] = v[2] * s; tl[k * 65 + n4 + 3] = v[3] * s;
  }
  __syncthreads();
  const int n = tid >> 3, k8 = (tid & 7) * 8;
  u32x4 w;
  w.x = cvt_pk_bf16(tl[(k8 + 0) * 65 + n], tl[(k8 + 1) * 65 + n]); w.y = cvt_pk_bf16(tl[(k8 + 2) * 65 + n], tl[(k8 + 3) * 65 + n]);
  w.z = cvt_pk_bf16(tl[(k8 + 4) * 65 + n], tl[(k8 + 5) * 65 + n]); w.w = cvt_pk_bf16(tl[(k8 + 6) * 65 + n], tl[(k8 + 7) * 65 + n]);
  for (int cp = 0; cp < ncopy; ++cp) *(u32x4*)(dst + (size_t)(r0 + n) * dld + c0 + cp * 1024 + k8) = w;
  __syncthreads();
}

__device__ void phase_convert(const Params& p, int layer, LAS unsigned char* lds, int parity, int first, int stride) {
  LAS float* tl = (LAS float*)lds;
  const float* gmix = p.in[2] + layer * 1024;
  const float* w_in = p.in[3] + (size_t)layer * 1024 * NPROJ;
  const float* w_gate = p.in[4] + (size_t)layer * 1024 * 3072;
  const float* w_branch = p.in[15] + (size_t)layer * 3 * 1024 * 1024;
  const float* w_out = p.in[16] + (size_t)layer * 1024 * 1024;
  const float* gffn = p.in[17] + layer * 1024;
  const float* w_fg = p.in[18] + (size_t)layer * 1024 * FF;
  const float* w_fu = p.in[19] + (size_t)layer * 1024 * FF;
  const float* w_fd = p.in[20] + (size_t)layer * FF * 1024;
  unsigned char* wb = p.ws + (parity ? WS_WB : 0);
  bf16_t* W1 = (bf16_t*)(wb + WS_W1); bf16_t* WG = (bf16_t*)(wb + WS_WG); bf16_t* W2 = (bf16_t*)(wb + WS_W2);
  bf16_t* W3 = (bf16_t*)(wb + WS_W3); bf16_t* W4 = (bf16_t*)(wb + WS_W4); bf16_t* W5 = (bf16_t*)(wb + WS_W5);
  for (int t = first; t < 6144; t += stride) {
    int i = t;
    const float* src; const float* scale = nullptr; bf16_t* dst; int sld, k0, n0, nvalid, dld, r0, ncopy = 1;
    if (i < 2240) { const int nt = i >> 4; k0 = (i & 15) * 64; n0 = nt * 64; src = w_in; sld = NPROJ; nvalid = NPROJ; scale = gmix; dst = W1; dld = 1024; r0 = n0; }
    else if ((i -= 2240) < 768) { const int nt = i >> 4; k0 = (i & 15) * 64; n0 = nt * 64; src = w_gate; sld = 3072; nvalid = 3072; scale = gmix; dst = WG; dld = 1024; r0 = n0; }
    else if ((i -= 768) < 768) { const int br = i >> 8, j = i & 255, nt = j >> 4; k0 = (j & 15) * 64; n0 = nt * 64; src = w_branch + (size_t)br * 1024 * 1024; sld = 1024; nvalid = 1024; dst = W2; dld = 1024; r0 = br * 1024 + n0; }
    else if ((i -= 768) < 256) { const int nt = i >> 4; k0 = (i & 15) * 64; n0 = nt * 64; src = w_out; sld = 1024; nvalid = 1024; dst = W3; dld = 1024; r0 = n0; }
    else if ((i -= 256) < 1408) { const int nt = i >> 4, pp = nt >> 2, half = (nt >> 1) & 1, sub = nt & 1; k0 = (i & 15) * 64; n0 = pp * 128 + sub * 64; src = half ? w_fu : w_fg; sld = FF; nvalid = FF; scale = gffn; dst = W4; dld = 1024; r0 = pp * 256 + half * 128 + sub * 64; }
    else { i -= 1408; const int nt = i / 44; k0 = (i % 44) * 64; n0 = nt * 64; src = w_fd; sld = 1024; nvalid = 1024; dst = W5; dld = FF; r0 = n0; }
    cvt_tile(tl, src, sld, k0, n0, nvalid, scale, dst, dld, r0, k0, ncopy);
  }
}

__device__ void phase_load_rows(const float* xin, bf16_t* xb, float* ssq) {
  const int tid_ = opaque_tid(); const int lane = tid_ & 63, wid = tid_ >> 6;
  for (int row = blockIdx.x * 8 + wid; row < T; row += gridDim.x * 8) {
    float sq = 0.f;
#pragma unroll
    for (int i = 0; i < 4; ++i) {
      const size_t off = (size_t)row * 1024 + i * 256 + lane * 4;
      const f32x4 v = *(const f32x4*)(xin + off);
      u32x2 w; w.x = cvt_pk_bf16(v[0], v[1]); w.y = cvt_pk_bf16(v[2], v[3]); *(u32x2*)(xb + off) = w;
      sq += (v[0] * v[0] + v[1] * v[1]) + (v[2] * v[2] + v[3] * v[3]);
    }
#pragma unroll
    for (int o = 1; o < 64; o <<= 1) sq += __shfl_xor(sq, o);
    if (lane < 16) ssq[((size_t)(lane >> 2) * T + row) * 4 + (lane & 3)] = lane == 0 ? sq : 0.f;
  }
}
__device__ void phase_final_norm(const bf16_t* xb, float* out, const float* ssq, const float* g) {
  const int tid_ = opaque_tid(); const int lane = tid_ & 63, wid = tid_ >> 6;
  for (int row = blockIdx.x * 8 + wid; row < T; row += gridDim.x * 8) {
    const float rs = row_rstd(ssq, row);
#pragma unroll
    for (int i = 0; i < 4; ++i) {
      const size_t off = (size_t)row * 1024 + i * 256 + lane * 4;
      const u32x2 w = *(const u32x2*)(xb + off); const f32x4 gg = *(const f32x4*)(g + i * 256 + lane * 4);
      const f32x4 v = (f32x4){bflo(w.x), bfhi(w.x), bflo(w.y), bfhi(w.y)};
      *(f32x4*)(out + off) = v * rs * gg;
    }
  }
}

__device__ void phase_conv(const bf16_t* proj, bf16_t* xc, const float* cw, const float* cb, int S) {
  const size_t total = (size_t)T * 192;
  const int tid_ = opaque_tid();
  for (size_t id = (size_t)blockIdx.x * 512 + tid_; id < total; id += (size_t)gridDim.x * 512) {
    const int t = (int)(id / 192), c8 = (int)(id % 192) * 8, pos = t % S;
    float a[8];
#pragma unroll
    for (int e = 0; e < 8; ++e) a[e] = cb[c8 + e];
#pragma unroll
    for (int tau = 0; tau < 4; ++tau) {
      const int pp = pos + tau - 2;
      if (pp >= 0 && pp < S) {
        const u32x4 v = *(const u32x4*)(proj + (size_t)(t + tau - 2) * PLD + C_XBC + c8);
        const float* w = cw + tau * 1536 + c8;
        a[0] += bflo(v.x) * w[0]; a[1] += bfhi(v.x) * w[1]; a[2] += bflo(v.y) * w[2]; a[3] += bfhi(v.y) * w[3];
        a[4] += bflo(v.z) * w[4]; a[5] += bfhi(v.z) * w[5]; a[6] += bflo(v.w) * w[6]; a[7] += bfhi(v.w) * w[7];
      }
    }
#pragma unroll
    for (int e = 0; e < 8; ++e) a[e] = siluf_(a[e]);
    u32x4 w; w.x = cvt_pk_bf16(a[0], a[1]); w.y = cvt_pk_bf16(a[2], a[3]); w.z = cvt_pk_bf16(a[4], a[5]); w.w = cvt_pk_bf16(a[6], a[7]);
    *(u32x4*)(xc + (size_t)t * 1536 + c8) = w;
  }
}

__device__ void phase_rope(bf16_t* proj, int S) {
  const int tid_ = opaque_tid();
  const size_t total = (size_t)T * 32;
  for (size_t id = (size_t)blockIdx.x * 512 + tid_; id < total; id += (size_t)gridDim.x * 512) {
    const int t = (int)(id >> 5), hd = (int)(id >> 3) & 3, ch = (int)id & 7;
    bf16_t* src = proj + (size_t)t * PLD + hd * 128 + ch * 8;
    const u32x4 q1 = *(const u32x4*)(src + C_RTQ), q2 = *(const u32x4*)(src + C_RTQ + 64), k1 = *(const u32x4*)(src + C_RTK), k2 = *(const u32x4*)(src + C_RTK + 64);
    const float pos = (float)(t % S);
    float cs[8], sn[8];
#pragma unroll
    for (int e = 0; e < 8; ++e) {
      const float inv = __builtin_amdgcn_exp2f(-(float)(ch * 8 + e) * (13.287712379549449f / 64.0f));
      float r = pos * inv * 0.15915494309189535f; r = r - floorf(r);
      sn[e] = __builtin_amdgcn_sinf(r); cs[e] = __builtin_amdgcn_cosf(r);
    }
    const float ksc = 0.08838834764831845f;
    const unsigned qa[4] = {q1.x, q1.y, q1.z, q1.w}, qb[4] = {q2.x, q2.y, q2.z, q2.w}, ka[4] = {k1.x, k1.y, k1.z, k1.w}, kb[4] = {k2.x, k2.y, k2.z, k2.w};
    unsigned oq1[4], oq2[4], ok1[4], ok2[4];
#pragma unroll
    for (int w = 0; w < 4; ++w) {
      const float a0 = bflo(qa[w]), a1 = bfhi(qa[w]), b0 = bflo(qb[w]), b1 = bfhi(qb[w]);
      oq1[w] = cvt_pk_bf16(a0 * cs[2 * w] - b0 * sn[2 * w], a1 * cs[2 * w + 1] - b1 * sn[2 * w + 1]);
      oq2[w] = cvt_pk_bf16(a0 * sn[2 * w] + b0 * cs[2 * w], a1 * sn[2 * w + 1] + b1 * cs[2 * w + 1]);
      const float e0 = bflo(ka[w]) * ksc, e1 = bfhi(ka[w]) * ksc, g0 = bflo(kb[w]) * ksc, g1 = bfhi(kb[w]) * ksc;
      ok1[w] = cvt_pk_bf16(e0 * cs[2 * w] - g0 * sn[2 * w], e1 * cs[2 * w + 1] - g1 * sn[2 * w + 1]);
      ok2[w] = cvt_pk_bf16(e0 * sn[2 * w] + g0 * cs[2 * w], e1 * sn[2 * w + 1] + g1 * cs[2 * w + 1]);
    }
    *(u32x4*)(src + C_RTQ) = (u32x4){oq1[0], oq1[1], oq1[2], oq1[3]};
    *(u32x4*)(src + C_RTQ + 64) = (u32x4){oq2[0], oq2[1], oq2[2], oq2[3]};
    *(u32x4*)(src + C_RTK) = (u32x4){ok1[0], ok1[1], ok1[2], ok1[3]};
    *(u32x4*)(src + C_RTK + 64) = (u32x4){ok2[0], ok2[1], ok2[2], ok2[3]};
  }
}

constexpr int MXP = 272;
constexpr int MX_Q = 0, MX_K = 34816, MX_KT = 69632, MX_VT = 104448, MX_HT = 121856, MX_V = 139264, MX_N = 155648, MX_VEC = 155904, MX_END = MX_VEC + 7 * 512 + 64;
constexpr int LDS_XB = MX_END > pg8::STAGE_BYTES ? MX_END : pg8::STAGE_BYTES;
constexpr int LDS_BYTES = LDS_XB + 16;

__device__ __forceinline__ int swz(int row, int col) { return row * MXP + col * 2; }
__device__ __forceinline__ bf16x8 ldfrag(LAS const unsigned char* base, int row0, int ks, int lane) {
  const int row = row0 + (lane & 31);
  return *(LAS const bf16x8*)(base + row * MXP + (lane >> 5) * 16 + ks * 32);
}
__device__ __forceinline__ u32x4 scale_pk(u32x4 v, float s) {
  u32x4 w; w.x = cvt_pk_bf16(bflo(v.x) * s, bfhi(v.x) * s); w.y = cvt_pk_bf16(bflo(v.y) * s, bfhi(v.y) * s);
  w.z = cvt_pk_bf16(bflo(v.z) * s, bfhi(v.z) * s); w.w = cvt_pk_bf16(bflo(v.w) * s, bfhi(v.w) * s); return w;
}

template <int BR, bool DEN>
__device__ void mixer_item(const Params& p, LAS unsigned char* lds, int layer, int S, int seq, int dir, int ht) {
  const int tid = opaque_tid(), wid = __builtin_amdgcn_readfirstlane(tid >> 6), lane = tid & 63, rb = wid >> 1, cb = wid & 1;
  const bf16_t* proj = (const bf16_t*)(p.ws + WS_PROJ);
  const bf16_t* xc = (const bf16_t*)(p.ws + WS_XC);
  const float* gs = (const float*)(p.ws + WS_GS);
  bf16_t* yout = (bf16_t*)(p.ws + (dir ? WS_YB : WS_YF));
  LAS float* vC = (LAS float*)(lds + MX_VEC); LAS float* vMu = vC + 128; LAS float* vW = vC + 256; LAS float* vR = vC + 384; LAS float* vCl = vC + 512; LAS float* vVs = vC + 640; LAS float* sc = vC + 896;
  constexpr bool STAB = (BR == 1);
  int hd, vt, ocol;
  if (BR == 0) { hd = ht; vt = 0; ocol = ht * 64; } else if (DEN) { hd = ht; vt = 0; ocol = 0; } else { hd = ht >> 2; vt = ht & 3; ocol = (BR == 1 ? 1024 : 2048) + hd * 256 + vt * 64; }
  float cst_a = 0.f, cst_b = 0.f, cst_c = 0.f;
  if (BR == 0) { cst_a = -expf(p.in[8][layer * 32 + dir * 16 + hd]); cst_b = p.in[9][layer * 32 + dir * 16 + hd]; }
  if (BR == 1) { cst_b = p.in[12][layer * 16 + (2 * dir) * 4 + hd]; cst_c = p.in[12][layer * 16 + (2 * dir + 1) * 4 + hd]; }
  if (BR == 2) { cst_a = logf(1.0f - exp2f(-5.0f - (4.0f / 3.0f) * (float)hd)); }
  const int nc = S / 128;
  const int seqbase = seq * S;
  f32x16 Hacc;
#pragma unroll
  for (int j = 0; j < 16; ++j) Hacc[j] = 0.f;
  float m_st = 0.f;
  { unsigned z0 = 0u; asm volatile("" : "+v"(z0)); const u32x4 zv = (u32x4){z0, z0, z0, z0};
    for (int i = tid; i < 64 * MXP / 16; i += 512) *(LAS u32x4*)(lds + MX_HT + i * 16) = zv;
    if (tid < 16) *(LAS u32x4*)(lds + MX_N + tid * 16) = zv; }

  u32x4 ra[8], rv[2]; float rg[4] = {0.f, 0.f, 0.f, 0.f};
#define MX_ISSUE_LOADS(ci_) do { \
    const int tk_ = seqbase + (ci_) * 128; \
    { \
      _Pragma("unroll") for (int it = 0; it < 4; ++it) { const int id = it * 512 + tid, row = id >> 4, ch = id & 15; \
        if (BR == 1) { const bf16_t* src = proj + (size_t)(tk_ + row) * PLD + hd * 128 + ch * 8; ra[it] = *(const u32x4*)(src + C_MLQ); ra[4 + it] = *(const u32x4*)(src + C_MLK); } \
        else if (BR == 2) { const bf16_t* src = proj + (size_t)(tk_ + row) * PLD + hd * 128 + ch * 8; ra[it] = *(const u32x4*)(src + C_RTQ); ra[4 + it] = *(const u32x4*)(src + C_RTK); } \
        else { const bf16_t* src = xc + (size_t)(tk_ + row) * 1536 + (hd >> 3) * 128 + ch * 8; ra[it] = *(const u32x4*)(src + 1280); ra[4 + it] = *(const u32x4*)(src + 1024); } } \
    } \
    _Pragma("unroll") for (int it = 0; it < 2; ++it) { const int id = it * 512 + tid, row = id >> 3, ch = id & 7; \
      if (DEN) rv[it] = (u32x4){0x3F803F80u, 0x3F803F80u, 0x3F803F80u, 0x3F803F80u}; \
      else if (BR == 0) rv[it] = *(const u32x4*)(xc + (size_t)(tk_ + row) * 1536 + hd * 64 + ch * 8); \
      else rv[it] = *(const u32x4*)(proj + (size_t)(tk_ + row) * PLD + (BR == 1 ? C_MLV : C_RTV) + hd * 256 + vt * 64 + ch * 8); } \
    if (wid == 0 && BR != 2) { const int q0_ = dir ? 127 - 2 * lane : 2 * lane, q1_ = dir ? 126 - 2 * lane : 2 * lane + 1; \
      if (BR == 0) { rg[0] = gs[(size_t)(tk_ + q0_) * 32 + dir * 16 + hd]; rg[1] = gs[(size_t)(tk_ + q1_) * 32 + dir * 16 + hd]; } \
      else { const float* gg = gs + (size_t)T * 32; rg[0] = gg[(size_t)(tk_ + q0_) * 16 + (2 * dir + 1) * 4 + hd]; rg[1] = gg[(size_t)(tk_ + q1_) * 16 + (2 * dir + 1) * 4 + hd]; \
        rg[2] = gg[(size_t)(tk_ + q0_) * 16 + (2 * dir) * 4 + hd]; rg[3] = gg[(size_t)(tk_ + q1_) * 16 + (2 * dir) * 4 + hd]; } } \
  } while (0)
  MX_ISSUE_LOADS(dir ? nc - 1 : 0);

  for (int c = 0; c < nc; ++c) {
    const int ci = dir ? nc - 1 - c : c;
    const int tok0 = seqbase + ci * 128;
    if (wid == 0) {
      const int j0 = 2 * lane, j1 = j0 + 1;
      const int p0 = dir ? 127 - j0 : j0, p1 = dir ? 127 - j1 : j1;
      float l0, l1, b0 = 0.f, b1 = 0.f, d0 = 1.f, d1 = 1.f;
      if (BR == 0) {
        d0 = softplusf_(rg[0] + cst_b); d1 = softplusf_(rg[1] + cst_b);
        l0 = d0 * cst_a; l1 = d1 * cst_a;
      } else if (BR == 1) {
        l0 = -softplusf_(-(rg[0] + cst_c)); l1 = -softplusf_(-(rg[1] + cst_c));
        b0 = rg[2] + cst_b; b1 = rg[3] + cst_b;
      } else { l0 = cst_a; l1 = cst_a; }
      float run = l0 + l1;
#pragma unroll
      for (int o = 1; o < 64; o <<= 1) { const float t = __shfl_up(run, o); if (lane >= o) run += t; }
      const float A1 = run, A0 = run - l1;
      const float A_end = __shfl(A1, 63);
      const float c0 = b0 - A0, c1 = b1 - A1;
      float mu0, mu1, mu_end;
      if (STAB) {
        float rm = fmaxf(c0, c1);
#pragma unroll
        for (int o = 1; o < 64; o <<= 1) { const float t = __shfl_up(rm, o); if (lane >= o) rm = fmaxf(rm, t); }
        const float ex = __shfl_up(rm, 1);
        const float pm0 = lane > 0 ? fmaxf(ex, c0) : c0, pm1 = rm;
        mu0 = fmaxf(m_st, pm0); mu1 = fmaxf(m_st, pm1); mu_end = fmaxf(m_st, __shfl(pm1, 63));
      } else { mu0 = -A0; mu1 = -A1; mu_end = -A_end; }
      vC[p0] = c0; vC[p1] = c1; vMu[p0] = mu0; vMu[p1] = mu1;
      vW[p0] = __expf(c0 - mu_end); vW[p1] = __expf(c1 - mu_end);
      vR[p0] = __expf(m_st - mu0); vR[p1] = __expf(m_st - mu1);
      vCl[p0] = STAB ? __expf(-A0 - mu0) : 0.f; vCl[p1] = STAB ? __expf(-A1 - mu1) : 0.f;
      vVs[p0] = d0; vVs[p1] = d1;
      if (lane == 0) sc[0] = __expf(m_st - mu_end);
      m_st = STAB ? A_end + mu_end : 0.f;
    }
    {
#pragma unroll
      for (int it = 0; it < 4; ++it) {
        const int id = it * 512 + tid, row = id >> 4, ch = id & 15;
        *(LAS u32x4*)(lds + MX_Q + swz(row, ch * 8)) = BR == 1 ? scale_pk(ra[it], 0.08838834764831845f) : ra[it];
        *(LAS u32x4*)(lds + MX_K + swz(row, ch * 8)) = ra[4 + it];
      }
    }
#pragma unroll
    for (int it = 0; it < 2; ++it) {
      const int id = it * 512 + tid, row = id >> 3, ch = id & 7;
      *(LAS u32x4*)(lds + MX_V + row * 128 + ch * 16) = rv[it];
    }
    __syncthreads();
    {
      const int dk = tid & 127, sg = tid >> 7, dv = tid & 63, sv = tid >> 6;
      unsigned short kr[32], vr[16];
      f32x4 w4[8], vs4[4];
#pragma unroll
      for (int i = 0; i < 32; ++i) kr[i] = *(LAS const bf16_t*)(lds + MX_K + swz(sg * 32 + i, dk));
#pragma unroll
      for (int i = 0; i < 16; ++i) vr[i] = *(LAS const bf16_t*)(lds + MX_V + (sv * 16 + i) * 128 + dv * 2);
#pragma unroll
      for (int i = 0; i < 8; ++i) w4[i] = *(LAS const f32x4*)(vW + sg * 32 + i * 4);
      if (BR == 0) {
#pragma unroll
        for (int i = 0; i < 4; ++i) vs4[i] = *(LAS const f32x4*)(vVs + sv * 16 + i * 4);
      }
      __builtin_amdgcn_sched_barrier(0);
#pragma unroll
      for (int s8 = 0; s8 < 4; ++s8) {
        float f[8];
#pragma unroll
        for (int e = 0; e < 8; ++e) f[e] = bf2f(kr[s8 * 8 + e]) * w4[s8 * 2 + (e >> 2)][e & 3];
        u32x4 w; w.x = cvt_pk_bf16(f[0], f[1]); w.y = cvt_pk_bf16(f[2], f[3]); w.z = cvt_pk_bf16(f[4], f[5]); w.w = cvt_pk_bf16(f[6], f[7]);
        *(LAS u32x4*)(lds + MX_KT + swz(dk, sg * 32 + s8 * 8)) = w;
      }
#pragma unroll
      for (int s8 = 0; s8 < 2; ++s8) {
        float f[8];
#pragma unroll
        for (int e = 0; e < 8; ++e) { f[e] = bf2f(vr[s8 * 8 + e]); if (BR == 0) f[e] *= vs4[s8 * 2 + (e >> 2)][e & 3]; }
        u32x4 w; w.x = cvt_pk_bf16(f[0], f[1]); w.y = cvt_pk_bf16(f[2], f[3]); w.z = cvt_pk_bf16(f[4], f[5]); w.w = cvt_pk_bf16(f[6], f[7]);
        *(LAS u32x4*)(lds + MX_VT + swz(dv, sv * 16 + s8 * 8)) = w;
      }
    }
    __syncthreads();
    f32x16 S0, S1, QH;
#pragma unroll
    for (int j = 0; j < 16; ++j) { S0[j] = 0.f; S1[j] = 0.f; QH[j] = 0.f; }
    {
      const float dec = sc[0];
#pragma unroll
      for (int j = 0; j < 16; ++j) { Hacc[j] *= dec; }
      bf16x8 fa[2], fb0[2], fb1[2], fhb[2], fka[2], fvb[2];
      fa[0] = ldfrag(lds + MX_Q, 32 * rb, 0, lane); fb0[0] = ldfrag(lds + MX_K, 64 * cb, 0, lane); fb1[0] = ldfrag(lds + MX_K, 64 * cb + 32, 0, lane);
      fhb[0] = ldfrag(lds + MX_HT, 32 * cb, 0, lane); fka[0] = ldfrag(lds + MX_KT, 32 * rb, 0, lane); fvb[0] = ldfrag(lds + MX_VT, 32 * cb, 0, lane);
#pragma unroll
      for (int ks = 0; ks < 8; ++ks) {
        const int cur = ks & 1, nxt = cur ^ 1;
        if (ks < 7) {
          fa[nxt] = ldfrag(lds + MX_Q, 32 * rb, ks + 1, lane); fb0[nxt] = ldfrag(lds + MX_K, 64 * cb, ks + 1, lane); fb1[nxt] = ldfrag(lds + MX_K, 64 * cb + 32, ks + 1, lane);
          fhb[nxt] = ldfrag(lds + MX_HT, 32 * cb, ks + 1, lane); fka[nxt] = ldfrag(lds + MX_KT, 32 * rb, ks + 1, lane); fvb[nxt] = ldfrag(lds + MX_VT, 32 * cb, ks + 1, lane);
        }
        __builtin_amdgcn_sched_barrier(0);
        S0 = __builtin_amdgcn_mfma_f32_32x32x16_bf16(fa[cur], fb0[cur], S0, 0, 0, 0);
        S1 = __builtin_amdgcn_mfma_f32_32x32x16_bf16(fa[cur], fb1[cur], S1, 0, 0, 0);
        QH = __builtin_amdgcn_mfma_f32_32x32x16_bf16(fa[cur], fhb[cur], QH, 0, 0, 0);
        Hacc = __builtin_amdgcn_mfma_f32_32x32x16_bf16(fka[cur], fvb[cur], Hacc, 0, 0, 0);
        __builtin_amdgcn_sched_barrier(0);
      }
    }
    __syncthreads();
    { const int cn = c + 1 < nc ? c + 1 : c; MX_ISSUE_LOADS(dir ? nc - 1 - cn : cn); }
    {
      const int sA = 64 * cb + (lane & 31), sB = sA + 32;
      const float cA = vC[sA], cB = vC[sB];
      float mu16[16];
#pragma unroll
      for (int j = 0; j < 16; ++j) mu16[j] = vMu[32 * rb + 8 * (j >> 2) + 4 * (lane >> 5) + (j & 3)];
      __builtin_amdgcn_sched_barrier(0);
#pragma unroll
      for (int j = 0; j < 16; ++j) {
        const int t = 32 * rb + 8 * (j >> 2) + 4 * (lane >> 5) + (j & 3);
        const float mu = mu16[j];
        bool okA, okB;
        if (dir == 0) { okA = sA <= t; okB = sB <= t; } else if (BR == 2) { okA = sA > t; okB = sB > t; } else { okA = sA >= t; okB = sB >= t; }
        const float pa = okA ? S0[j] * __expf(cA - mu) : 0.f, pb = okB ? S1[j] * __expf(cB - mu) : 0.f;
        *(LAS bf16_t*)(lds + MX_Q + swz(t, sA)) = f2bf(pa);
        *(LAS bf16_t*)(lds + MX_Q + swz(t, sB)) = f2bf(pb);
      }
#pragma unroll
      for (int g4 = 0; g4 < 4; ++g4) {
        const int dk0 = 32 * rb + 8 * g4 + 4 * (lane >> 5), dvr = 32 * cb + (lane & 31);
        u32x2 w; w.x = cvt_pk_bf16(Hacc[4 * g4 + 0], Hacc[4 * g4 + 1]); w.y = cvt_pk_bf16(Hacc[4 * g4 + 2], Hacc[4 * g4 + 3]);
        *(LAS u32x2*)(lds + MX_HT + swz(dvr, dk0)) = w;
      }
    }
    __syncthreads();
    {
      float rsc[16];
#pragma unroll
      for (int j = 0; j < 16; ++j) { const int t = 32 * rb + 8 * (j >> 2) + 4 * (lane >> 5) + (j & 3); rsc[j] = vR[t]; QH[j] *= rsc[j]; }
      bf16x8 pa[2], pv[2];
      pa[0] = ldfrag(lds + MX_Q, 32 * rb, 0, lane); pv[0] = ldfrag(lds + MX_VT, 32 * cb, 0, lane);
#pragma unroll
      for (int ks = 0; ks < 8; ++ks) {
        const int cur = ks & 1, nxt = cur ^ 1;
        if (ks < 7) { pa[nxt] = ldfrag(lds + MX_Q, 32 * rb, ks + 1, lane); pv[nxt] = ldfrag(lds + MX_VT, 32 * cb, ks + 1, lane); }
        __builtin_amdgcn_sched_barrier(0);
        QH = __builtin_amdgcn_mfma_f32_32x32x16_bf16(pa[cur], pv[cur], QH, 0, 0, 0);
        __builtin_amdgcn_sched_barrier(0);
      }
#pragma unroll
      for (int j = 0; j < 16; ++j) {
        const int t = 32 * rb + 8 * (j >> 2) + 4 * (lane >> 5) + (j & 3);
        const float y = QH[j];
        if (DEN) { if (cb == 0 && (lane & 31) == 0) { float* dp = (float*)(p.ws + WS_DEN) + (((size_t)(dir * 4 + hd) * T) + tok0 + t) * 2; dp[0] = y; dp[1] = vCl[t]; } }
        else yout[(size_t)(tok0 + t) * 3072 + ocol + 32 * cb + (lane & 31)] = f2bf(y);
      }
    }
    __syncthreads();
  }
}

#undef MX_ISSUE_LOADS
__device__ void phase_mixer(const Params& p, LAS unsigned char* lds, int layer, int S, int conv_layer, int conv_parity) {
  const int nseq = T / S, nitems = nseq * 2 * 52;
  for (int it = blockIdx.x; it < nitems; it += gridDim.x) {
    const int ht_ord = it / (nseq * 2), rem = it % (nseq * 2), seq = rem >> 1, dir = rem & 1;
#ifdef ONLY_BR
    mixer_item<ONLY_BR, false>(p, lds, layer, S, seq, dir, ht_ord & 15);
#else
    if (ht_ord < 16) mixer_item<1, false>(p, lds, layer, S, seq, dir, ht_ord);
    else if (ht_ord < 20) mixer_item<1, true>(p, lds, layer, S, seq, dir, ht_ord - 16);
    else if (ht_ord < 36) mixer_item<2, false>(p, lds, layer, S, seq, dir, ht_ord - 20);
    else mixer_item<0, false>(p, lds, layer, S, seq, dir, ht_ord - 36);
#endif
  }
  if (conv_layer >= 0) {
    const int G = gridDim.x, rem = nitems % G, nconv = G - rem;
    if ((int)blockIdx.x >= rem) phase_convert(p, conv_layer, lds, conv_parity, (int)blockIdx.x - rem, nconv);
  }
}

__device__ void phase_post(const Params& p, int layer) {
  const int tid_ = opaque_tid(); const int lane = tid_ & 63, wid = tid_ >> 6;
  const bf16_t* proj = (const bf16_t*)(p.ws + WS_PROJ); const bf16_t* xc = (const bf16_t*)(p.ws + WS_XC);
  const bf16_t* yf = (const bf16_t*)(p.ws + WS_YF); const bf16_t* yb = (const bf16_t*)(p.ws + WS_YB);
  const float* den = (const float*)(p.ws + WS_DEN);
  bf16_t* act = (bf16_t*)(p.ws + WS_PROJ) + ACT_COL;
  const float* dsk = p.in[10] + layer * 16; const float* g_ssd = p.in[11] + layer * 1024; const float* g_ml = p.in[13] + layer * 1024; const float* g_rt = p.in[14] + layer * 1024;
  for (int row = blockIdx.x * 8 + wid; row < T; row += gridDim.x * 8) {
    u32x4 wf[3][2], wb[3][2], wg[3][2], wx[2]; float dn[2][4];
#pragma unroll
    for (int br = 0; br < 3; ++br)
#pragma unroll
      for (int k = 0; k < 2; ++k) {
        const int c = br * 1024 + k * 512 + lane * 8;
        wf[br][k] = __builtin_nontemporal_load((const u32x4*)(yf + (size_t)row * 3072 + c)); wb[br][k] = __builtin_nontemporal_load((const u32x4*)(yb + (size_t)row * 3072 + c));
        const int gcol = (br == 0 ? C_Z : (br == 1 ? C_MLO : C_RTG)) + k * 512 + lane * 8;
        wg[br][k] = __builtin_nontemporal_load((const u32x4*)(proj + (size_t)row * PLD + gcol));
      }
#pragma unroll
    for (int k = 0; k < 2; ++k) {
      wx[k] = *(const u32x4*)(xc + (size_t)row * 1536 + k * 512 + lane * 8);
      const int h = k * 2 + (lane >> 5);
      const float* df = den + (((size_t)(0 * 4 + h) * T) + row) * 2; const float* db = den + (((size_t)(1 * 4 + h) * T) + row) * 2;
      dn[k][0] = df[0]; dn[k][1] = df[1]; dn[k][2] = db[0]; dn[k][3] = db[1];
    }
#pragma unroll
    for (int br = 0; br < 3; ++br) {
      float y[2][8], gt[2][8], sq[2];
#pragma unroll
      for (int k = 0; k < 2; ++k) {
        const unsigned aa[4] = {wf[br][k].x, wf[br][k].y, wf[br][k].z, wf[br][k].w}, bb[4] = {wb[br][k].x, wb[br][k].y, wb[br][k].z, wb[br][k].w}, gg[4] = {wg[br][k].x, wg[br][k].y, wg[br][k].z, wg[br][k].w};
        float nf = 1.f, nb = 1.f;
        if (br == 1) { nf = 1.0f / fmaxf(fabsf(dn[k][0]), dn[k][1]); nb = 1.0f / fmaxf(fabsf(dn[k][2]), dn[k][3]); }
#pragma unroll
        for (int w = 0; w < 4; ++w) {
          y[k][2 * w] = bflo(aa[w]) * nf + bflo(bb[w]) * nb; y[k][2 * w + 1] = bfhi(aa[w]) * nf + bfhi(bb[w]) * nb;
          gt[k][2 * w] = bflo(gg[w]); gt[k][2 * w + 1] = bfhi(gg[w]);
        }
        if (br == 0) {
          const float dd = dsk[k * 8 + (lane >> 3)];
          const unsigned xx[4] = {wx[k].x, wx[k].y, wx[k].z, wx[k].w};
#pragma unroll
          for (int w = 0; w < 4; ++w) { y[k][2 * w] += bflo(xx[w]) * dd; y[k][2 * w + 1] += bfhi(xx[w]) * dd; }
#pragma unroll
          for (int e = 0; e < 8; ++e) y[k][e] *= siluf_(gt[k][e]);
        }
        float q = 0.f;
#pragma unroll
        for (int e = 0; e < 8; ++e) q += y[k][e] * y[k][e];
        q += __shfl_xor(q, 1); q += __shfl_xor(q, 2); q += __shfl_xor(q, 4); q += __shfl_xor(q, 8); q += __shfl_xor(q, 16);
        sq[k] = q;
      }
      float rs[2];
      if (br == 0) { float t = sq[0] + sq[1]; t += __shfl_xor(t, 32); rs[0] = rs[1] = rsqrtf(t * (1.0f / 1024.0f) + EPS); }
      else { rs[0] = rsqrtf(sq[0] * (1.0f / 256.0f) + EPS); rs[1] = rsqrtf(sq[1] * (1.0f / 256.0f) + EPS); }
#pragma unroll
      for (int k = 0; k < 2; ++k) {
        const float* gn = (br == 0 ? g_ssd : (br == 1 ? g_ml : g_rt)) + k * 512 + lane * 8;
        const f32x4 g0 = *(const f32x4*)gn, g1 = *(const f32x4*)(gn + 4);
        unsigned o[4];
#pragma unroll
        for (int e = 0; e < 8; e += 2) {
          float v0 = y[k][e] * rs[k] * (e < 4 ? g0[e] : g1[e - 4]), v1 = y[k][e + 1] * rs[k] * (e < 4 ? g0[e + 1] : g1[e - 3]);
          if (br == 1) { v0 *= sigmoidf_(gt[k][e]); v1 *= sigmoidf_(gt[k][e + 1]); }
          if (br == 2) { v0 *= siluf_(gt[k][e]); v1 *= siluf_(gt[k][e + 1]); }
          o[e >> 1] = cvt_pk_bf16(v0, v1);
        }
        *(u32x4*)(act + (size_t)row * PLD + br * 1024 + k * 512 + lane * 8) = (u32x4){o[0], o[1], o[2], o[3]};
      }
    }
  }
}

#ifndef PH_MASK
#define PH_MASK 0xFFFF
#endif
#ifndef REP_SYNC
#define REP_SYNC 1
#endif
#ifndef REP_MIX
#define REP_MIX 1
#endif
#ifndef REP_G1
#define REP_G1 1
#endif
#ifndef REP_MISC
#define REP_MISC 1
#endif
#ifndef REP_G2
#define REP_G2 1
#endif
#ifndef REP_G4
#define REP_G4 1
#endif
#define XB_TMO      128
#define XB_XCNT(j)  (256  + 64 * (j))
#define XB_XSUB(j)  (1280 + 64 * (j))
#define XB_XGEN(j)  (2304 + 64 * (j))
#define XB_TOP      3328
#define XB_TOPGEN   3392
#define XCD_BAR_WORDS 3456
#define XB_SPIN_CAP (1u << 22)

__device__ __forceinline__ unsigned xb_ld(unsigned* p)              { return __hip_atomic_load(p, __ATOMIC_RELAXED, __HIP_MEMORY_SCOPE_AGENT); }
__device__ __forceinline__ unsigned xb_add(unsigned* p, unsigned v) { return __hip_atomic_fetch_add(p, v, __ATOMIC_RELAXED, __HIP_MEMORY_SCOPE_AGENT); }
__device__ __forceinline__ unsigned xb_xcc_id() { return (unsigned)__builtin_amdgcn_s_getreg((3 << 11) | 20) & 0xFu; }
#define XB_SPIN(cond, bar) do { unsigned _sp = 0; while (cond) { __builtin_amdgcn_s_sleep(1); \
    if ((++_sp & 255u) == 0u) { if (xb_ld(&(bar)[XB_TMO])) break; if (_sp > XB_SPIN_CAP) { atomicAdd(&(bar)[XB_TMO], 1u); break; } } } } while (0)
struct XcdBarrier { unsigned* bar; unsigned x; volatile LAS unsigned* st; };
__device__ __forceinline__ XcdBarrier xcd_barrier_post(unsigned* bar, volatile LAS unsigned* st) {
    XcdBarrier b; b.bar = bar; b.x = xb_xcc_id(); b.st = st;
    if (threadIdx.x == 0) (void)xb_add(&bar[XB_XCNT(b.x)], 1u);
    return b;
}
__device__ __forceinline__ void xcd_barrier_complete(unsigned* bar, unsigned x, unsigned& nloc, unsigned& nx) {
    const unsigned G = gridDim.x * gridDim.y * gridDim.z;
    unsigned sum, cnt, mine, sp = 0u;
    for (;;) {
        sum = 0u; cnt = 0u; mine = 0u;
#pragma unroll
        for (unsigned j = 0; j < 16; ++j) { const unsigned c = xb_ld(&bar[XB_XCNT(j)]); sum += c; cnt += (c > 0u) ? 1u : 0u; mine = (j == x) ? c : mine; }
        if (sum == G) break;
        __builtin_amdgcn_s_sleep(1);
        if ((++sp & 255u) == 0u) { if (xb_ld(&bar[XB_TMO])) break; if (sp > XB_SPIN_CAP) { atomicAdd(&bar[XB_TMO], 1u); break; } }
    }
    nloc = mine > 0u ? mine : 1u; nx = cnt > 0u ? cnt : 1u;
}
__device__ __forceinline__ void xcd_barrier(const XcdBarrier& b) {
    asm volatile("s_waitcnt vmcnt(0)" ::: "memory");
    __syncthreads();
    if (threadIdx.x == 0) {
        unsigned* bar = b.bar;
        __builtin_amdgcn_s_waitcnt(0);
        unsigned nloc = b.st[0], nx = b.st[1];
        if (nloc == 0u) { xcd_barrier_complete(bar, b.x, nloc, nx); b.st[0] = nloc; b.st[1] = nx; }
        const unsigned old = xb_add(&bar[XB_XSUB(b.x)], 1u);
        const unsigned gen = old / nloc;
        if (old + 1u == (gen + 1u) * nloc) {
            __builtin_amdgcn_fence(__ATOMIC_RELEASE, "agent");
            asm volatile("s_waitcnt vmcnt(0)" ::: "memory");
            const unsigned og = xb_add(&bar[XB_TOP], 1u);
            const unsigned tg = og / nx;
            if (og + 1u == (tg + 1u) * nx) xb_add(&bar[XB_TOPGEN], 1u);
            else XB_SPIN(xb_ld(&bar[XB_TOPGEN]) == tg, bar);
            __builtin_amdgcn_fence(__ATOMIC_ACQUIRE, "agent");
            xb_add(&bar[XB_XGEN(b.x)], 1u);
            asm volatile("s_waitcnt vmcnt(0)" ::: "memory");
        } else {
            XB_SPIN(xb_ld(&bar[XB_XGEN(b.x)]) == gen, bar);
            __builtin_amdgcn_fence(__ATOMIC_ACQUIRE, "agent");
            asm volatile("s_waitcnt vmcnt(0)" ::: "memory");
        }
    }
    __syncthreads();
}
#define GSYNC() do { for (int r_ = 0; r_ < REP_SYNC; ++r_) { XcdBarrier xb_; xb_.bar = (unsigned*)(p.ws + WS_BAR); xb_.x = xb_xcc_id(); xb_.st = (volatile LAS unsigned*)(lds + LDS_XB); xcd_barrier(xb_); } } while (0)
__global__ void __launch_bounds__(512, 2) fwd_megakernel(Params p) {
  extern __shared__ __attribute__((aligned(16))) unsigned char smem[];
  LAS unsigned char* lds = (LAS unsigned char*)smem;
  cg::grid_group grid = cg::this_grid();
  if (threadIdx.x < 4) ((LAS unsigned*)(lds + LDS_XB))[threadIdx.x] = 0u;
  __syncthreads();
  (void)xcd_barrier_post((unsigned*)(p.ws + WS_BAR), (volatile LAS unsigned*)(lds + LDS_XB));
  grid.sync();
  const int G = gridDim.x, bid = blockIdx.x;
#define WSP(T_, off) ((T_*)(p.ws + (off)))
  for (int pl = 0; pl < 12; ++pl) {
    int pass = pl >> 2, layer = pl & 3;
    asm volatile("" : "+s"(pass), "+s"(layer));
    const int S = pass == 0 ? 4096 : 8192;
    {
      if (pl == 0) phase_convert(p, 0, lds, 0, (int)blockIdx.x, (int)gridDim.x);
      unsigned char* wcur = p.ws + ((pl & 1) ? WS_WB : 0);
      if (layer == 0) {
        if ((PH_MASK & 2) && pass > 0) phase_final_norm(WSP(bf16_t, WS_XB), p.out + (size_t)(pass - 1) * T * 1024, WSP(float, WS_SSQ), p.in[21]);
        GSYNC();
        if (PH_MASK & 2) phase_load_rows(pass == 0 ? p.in[0] : p.in[1] + (size_t)(pass - 1) * T * 1024, WSP(bf16_t, WS_XB), WSP(float, WS_SSQ));
      }
      GSYNC();
      for (int r_ = 0; r_ < REP_G1; ++r_) if (PH_MASK & 4) { pg8::Gemm g{WSP(bf16_t, WS_XB), (bf16_t*)(wcur + WS_W1), T, PLD, 1024, 1024, 1 << 20, 0}; pg8::StaticOrder so; so.init(T, PLD, G, bid); EpiProj E{WSP(bf16_t, WS_PROJ), WSP(float, WS_GS), WSP(float, WS_SSQ)}; pg8::gemm_phase(lds, g, so, E); }
      GSYNC();
      phase_rope(WSP(bf16_t, WS_PROJ), S);
      for (int r_ = 0; r_ < REP_MISC; ++r_) if (PH_MASK & 8) phase_conv(WSP(bf16_t, WS_PROJ), WSP(bf16_t, WS_XC), p.in[6] + layer * 4 * 1536, p.in[7] + layer * 1536, S);
      GSYNC();
      for (int r_ = 0; r_ < REP_MIX; ++r_) if (PH_MASK & 16) phase_mixer(p, lds, layer, S, pl < 11 ? ((pl + 1) & 3) : -1, (pl + 1) & 1);
      GSYNC();
      for (int ph_ = 0; ph_ < 2; ++ph_) {
        if (((ph_ ^ (bid >> 3)) & 1) != 0) { for (int r_ = 0; r_ < REP_MISC; ++r_) if (PH_MASK & 32) phase_post(p, layer); }
        else { for (int r2_ = 0; r2_ < REP_G2; ++r2_) if (PH_MASK & 64) { pg8::Gemm g{WSP(bf16_t, WS_XB), (bf16_t*)(wcur + WS_WG), T, 3072, 1024, 1024, 1 << 20, 0}; pg8::StaticOrder so; so.init(T, 3072, G, bid); EpiGate E{WSP(bf16_t, WS_GATE), p.in[5] + layer * 3072, WSP(float, WS_SSQ)}; pg8::gemm_phase(lds, g, so, E); } }
      }
      GSYNC();
      if (PH_MASK & 128) { pg8::Gemm g{WSP(bf16_t, WS_PROJ) + ACT_COL, (bf16_t*)(wcur + WS_W2), T, 3072, 1024, PLD, 4, 1024}; pg8::BranchOrder so; so.init(T, G, bid); EpiBranch E{WSP(bf16_t, WS_GATE), WSP(bf16_t, WS_GATED)}; pg8::gemm_phase(lds, g, so, E); }
      GSYNC();
      if (PH_MASK & 256) { pg8::Gemm g{WSP(bf16_t, WS_GATED), (bf16_t*)(wcur + WS_W3), T, 1024, 1024, 1024, 1 << 20, 0}; pg8::StaticOrder so; so.init(T, 1024, G, bid); EpiRes E{WSP(bf16_t, WS_XB), WSP(float, WS_SSQ)}; pg8::gemm_phase(lds, g, so, E); }
      GSYNC();
      for (int r4_ = 0; r4_ < REP_G4; ++r4_) if (PH_MASK & 512) { pg8::Gemm g{WSP(bf16_t, WS_XB), (bf16_t*)(wcur + WS_W4), T, 5632, 1024, 1024, 1 << 20, 0}; pg8::StaticOrder so; so.init(T, 5632, G, bid); EpiFfn E{WSP(bf16_t, WS_HID), WSP(float, WS_SSQ)}; pg8::gemm_phase(lds, g, so, E); }
      GSYNC();
      if (PH_MASK & 1024) { pg8::Gemm g{WSP(bf16_t, WS_HID), (bf16_t*)(wcur + WS_W5), T, 1024, FF, FF, 1 << 20, 0}; pg8::StaticOrder so; so.init(T, 1024, G, bid); EpiRes E{WSP(bf16_t, WS_XB), WSP(float, WS_SSQ)}; pg8::gemm_phase(lds, g, so, E); }
      GSYNC();
    }
  }
  phase_final_norm(WSP(bf16_t, WS_XB), p.out + (size_t)2 * T * 1024, WSP(float, WS_SSQ), p.in[21]);
}

extern "C" void kernel_launch(void* const* d_in, const int* in_sizes, int n_in, void* d_out, int out_size, void* d_ws, size_t ws_size, hipStream_t stream) {
  static int grid_blocks = 0;
  if (!grid_blocks) {
    int dev = 0, cus = 0, per_cu = 0;
    (void)hipGetDevice(&dev);
    (void)hipDeviceGetAttribute(&cus, hipDeviceAttributeMultiprocessorCount, dev);
    if (hipFuncSetAttribute((const void*)fwd_megakernel, hipFuncAttributeMaxDynamicSharedMemorySize, LDS_BYTES) != hipSuccess) fprintf(stderr, "hipFuncSetAttribute failed\n");
    if (hipOccupancyMaxActiveBlocksPerMultiprocessor(&per_cu, (const void*)fwd_megakernel, 512, LDS_BYTES) != hipSuccess || per_cu < 1) { fprintf(stderr, "occupancy query: %d\n", per_cu); per_cu = 1; }
    (void)hipGetLastError();
    grid_blocks = cus * per_cu;
    if (ws_size < WS_TOTAL || n_in != 22) { fprintf(stderr, "kernel_launch: workspace %zu < %zu or n_in %d\n", ws_size, (size_t)WS_TOTAL, n_in); }
  }
  Params p{};
  for (int i = 0; i < 22; ++i) p.in[i] = (const float*)d_in[i];
  p.out = (float*)d_out; p.ws = (unsigned char*)d_ws;
  (void)hipMemsetAsync((unsigned char*)d_ws + WS_BAR, 0, XCD_BAR_WORDS * 4, stream);
  void* args[] = {&p};
  hipError_t e = hipLaunchCooperativeKernel((const void*)fwd_megakernel, dim3(grid_blocks), dim3(512), args, LDS_BYTES, stream);
  if (e != hipSuccess) fprintf(stderr, "cooperative launch failed: %s (grid %d)\n", hipGetErrorString(e), grid_blocks);
}
```

```cpp
#include <hip/hip_runtime.h>
#include <hip/hip_cooperative_groups.h>
#include <cstdio>
namespace cg = cooperative_groups;
#define LAS __attribute__((address_space(3)))
typedef unsigned short bf16_t;
typedef short bf16x8 __attribute__((ext_vector_type(8)));
typedef float f32x4 __attribute__((ext_vector_type(4)));
typedef float f32x16 __attribute__((ext_vector_type(16)));
typedef unsigned u32x4 __attribute__((ext_vector_type(4)));
typedef unsigned u32x2 __attribute__((ext_vector_type(2)));

constexpr int D = 1024, T = 16384, FF = 2816, NPROJ = 8752, PLD = 8960;
constexpr int C_Z = 0, C_XBC = 1024, C_MLQ = 2560, C_RTQ = 3072, C_RTK = 3584, C_MLK = 4096, C_MLV = 4608, C_MLO = 5632, C_RTV = 6656, C_RTG = 7680, C_DT = 8704, C_MLG = 8736;
constexpr float EPS = 1e-6f;

constexpr size_t WS_W1 = 0;
constexpr size_t WS_WG = WS_W1 + (size_t)PLD * 1024 * 2;
constexpr size_t WS_W2 = WS_WG + (size_t)3072 * 1024 * 2;
constexpr size_t WS_W3 = WS_W2 + (size_t)3072 * 1024 * 2;
constexpr size_t WS_W4 = WS_W3 + (size_t)1024 * 3072 * 2;
constexpr size_t WS_W5 = WS_W4 + (size_t)5632 * 1024 * 2;
constexpr size_t WS_XB = WS_W5 + (size_t)1024 * FF * 2;
constexpr size_t WS_SSQ = WS_XB + (size_t)T * 1024 * 2;
constexpr size_t WS_GS = WS_SSQ + (size_t)T * 16 * 4;
constexpr size_t WS_PROJ = WS_GS + (size_t)T * 48 * 4;
constexpr size_t WS_XC = WS_PROJ + (size_t)T * PLD * 2;
constexpr size_t WS_YF = WS_XC + (size_t)T * 1536 * 2;
constexpr size_t WS_YB = WS_YF + (size_t)T * 3072 * 2;
constexpr size_t WS_ACT = WS_YB + (size_t)T * 3072 * 2;
constexpr size_t WS_END = WS_ACT + (size_t)T * 3072 * 2;
constexpr size_t WS_HID = WS_PROJ;
constexpr size_t WS_GATE = WS_ACT;
constexpr int ACT_COL = 1024;
constexpr size_t WS_GATED = WS_YF;
constexpr size_t WS_BAR = WS_END;
constexpr size_t WS_WB = WS_END + 16384;
constexpr size_t WS_DEN = WS_WB + WS_XB;
constexpr size_t WS_TOTAL = WS_DEN + (size_t)2 * 4 * T * 2 * 4;

struct Params {
  const float* in[22];
  float* out;
  unsigned char* ws;
};

__device__ __forceinline__ int opaque_tid() { int t = threadIdx.x; asm volatile("" : "+v"(t)); return t; }
typedef __bf16 bf16x2_t __attribute__((ext_vector_type(2)));
typedef float f32x2_t __attribute__((ext_vector_type(2)));
__device__ __forceinline__ unsigned cvt_pk_bf16(float lo, float hi) { const f32x2_t v = {lo, hi}; const bf16x2_t b = __builtin_convertvector(v, bf16x2_t); return __builtin_bit_cast(unsigned, b); }
__device__ __forceinline__ bf16_t f2bf(float f) { return (bf16_t)(cvt_pk_bf16(f, 0.f) & 0xffffu); }
__device__ __forceinline__ float bf2f(bf16_t b) { return __uint_as_float(((unsigned)b) << 16); }
__device__ __forceinline__ float bflo(unsigned w) { return __uint_as_float(w << 16); }
__device__ __forceinline__ float bfhi(unsigned w) { return __uint_as_float(w & 0xffff0000u); }
__device__ __forceinline__ float sigmoidf_(float x) { return __builtin_amdgcn_rcpf(1.f + __expf(-x)); }
__device__ __forceinline__ float siluf_(float x) { return x * __builtin_amdgcn_rcpf(1.f + __expf(-x)); }
__device__ __forceinline__ float softplusf_(float x) {
  const float e = __expf(fminf(x, 20.f));
  const float sp = e < 2e-3f ? e * (1.f - 0.5f * e + 0.33333334f * e * e) : __logf(1.f + e);
  return x > 20.f ? x : sp;
}

namespace pg8 {
constexpr int BM = 256, BK = 64, HALF = 128, HTB = HALF * BK * 2, STAGE_BYTES = 8 * HTB, NXCD = 8, WGM = 8;
__host__ __device__ __forceinline__ int lds_byte(int r, int c) { const int st = (r >> 4) * 2 + (c >> 5), rr = r & 15, cc = c & 31, ob = rr * 64 + cc * 2; return st * 1024 + (ob ^ (((ob >> 9) & 1) << 5)); }
__host__ __device__ __forceinline__ void stage_rc(int b, int& R, int& C) { const int st = b / 1024, sb = b % 1024, swz = sb ^ (((sb >> 9) & 1) << 5); R = (st >> 1) * 16 + swz / 64; C = (st & 1) * 32 + (swz % 64) / 2; }
__host__ __device__ __forceinline__ int perm32(int rho) { const int n = rho >> 4, i = rho & 15; return 8 * (i >> 2) + 4 * n + (i & 3); }
struct Unit { int pm, pn; };
struct Gemm { const bf16_t* A; const bf16_t* Bt; int M, N, K, lda; int asel_div; int asel_stride; };
struct StaticOrder {
    int nM, nN, nwg, G, c;
    __device__ void init(int M, int N, int G_, int c_) { nM = M / BM; nN = N / BM; nwg = nM * nN; G = G_; c = c_; }
    __device__ bool next(int i, Unit& u) const {
        const long L = (long)i * G + c; if (L >= nwg) return false;
        int wgid = (int)L; { const int q = nwg / NXCD, r = nwg % NXCD, xcd = wgid % NXCD, off = wgid / NXCD; wgid = (xcd < r ? xcd * (q + 1) : r * (q + 1) + (xcd - r) * q) + off; }
        const int nig = WGM * nN, gid = wgid / nig, fm = gid * WGM, gsz = (nM - fm) < WGM ? (nM - fm) : WGM;
        u.pm = fm + ((wgid % nig) % gsz); u.pn = (wgid % nig) / gsz; return true;
    }
};

struct BranchOrder {
    StaticOrder so;
    __device__ void init(int M, int G_, int c_) { so.init(M, 1024, G_, c_); }
    __device__ bool next(int i, Unit& u) const { Unit t; const int q = i / 3; if (!so.next(q, t)) return false; u.pm = t.pm; u.pn = (i - 3 * q) * 4 + t.pn; return true; }
};
template <class Epi, class Sched>
__device__ __forceinline__ void gemm_phase(LAS unsigned char* lds, const Gemm g, const Sched& S, const Epi& E) {
    const int tid = opaque_tid(), wid = __builtin_amdgcn_readfirstlane(tid >> 6), lane = tid & 63, wr = wid >> 2, wc = wid & 3, fr = lane & 15, fq = lane >> 4;
    const int K = g.K, nt = K / BK;
    unsigned voffA[2], voffB[2];
#pragma unroll
    for (int i = 0; i < 2; ++i) { int R, C; stage_rc(tid * 16 + i * 8192, R, C); const int Rb = Epi::PERM ? ((R & ~31) + perm32(R & 31)) : R;
        voffA[i] = (unsigned)(R * g.lda + C) * 2u; voffB[i] = (unsigned)(Rb * K + C) * 2u; }
    const size_t kstep = (size_t)(BK * 2);
    const size_t hstepA = (size_t)HALF * g.lda * 2, tstepA = 2 * hstepA;
    const size_t hstepB = (size_t)HALF * K * 2, tstepB = 2 * hstepB;
    const unsigned ldsw = (unsigned)wid * 1024u;
    const int aoff = lds_byte(wr * 64 + fr, fq * 8), boff = lds_byte(wc * 32 + fr, fq * 8);
#define PG8_SA(b, h) (((b) * 2 + (h)) * HTB)
#define PG8_SB(b, h) ((4 + (b) * 2 + (h)) * HTB)
#define PG8_STAGE(bufoff, gbase, voff) do { _Pragma("unroll") for (int _i = 0; _i < 2; ++_i) \
        __builtin_amdgcn_global_load_lds((const unsigned*)((const char*)(gbase) + (voff)[_i]), (LAS unsigned*)(lds + (bufoff) + ldsw + _i * 8192), 16, 0, 0); } while (0)
#define PG8_LDA(dst, b, h) do { _Pragma("unroll") for (int m = 0; m < 4; ++m) _Pragma("unroll") for (int k = 0; k < 2; ++k) dst[m][k] = *(const LAS bf16x8*)(lds + PG8_SA(b, h) + aoff + m * 2048 + k * 1024); } while (0)
#define PG8_LDB(dst, b, h) do { _Pragma("unroll") for (int n = 0; n < 2; ++n) _Pragma("unroll") for (int k = 0; k < 2; ++k) dst[n][k] = *(const LAS bf16x8*)(lds + PG8_SB(b, h) + boff + n * 2048 + k * 1024); } while (0)
#define PG8_MMA(ai, bj, At, Bt) do { __builtin_amdgcn_s_setprio(1); _Pragma("unroll") for (int m = 0; m < 4; ++m) _Pragma("unroll") for (int n = 0; n < 2; ++n) _Pragma("unroll") for (int k = 0; k < 2; ++k) \
        acc[ai][bj][m][n] = __builtin_amdgcn_mfma_f32_16x16x32_bf16(Bt[n][k], At[m][k], acc[ai][bj][m][n], 0, 0, 0); __builtin_amdgcn_s_setprio(0); } while (0)
#define PG8_WAIT_V(n) asm volatile("s_waitcnt vmcnt(" #n ")" ::: "memory")
#define PG8_WAIT_L(n) asm volatile("s_waitcnt lgkmcnt(" #n ")" ::: "memory")
#define PG8_BAR __builtin_amdgcn_s_barrier()
#define PG8_SCHED __builtin_amdgcn_sched_barrier(0)
    Unit cur, nxt; int ui = 0;
    if (!S.next(0, cur)) return;
    f32x4 acc[2][2][4][2];
#pragma unroll
    for (int a = 0; a < 2; ++a)
#pragma unroll
        for (int b = 0; b < 2; ++b)
#pragma unroll
            for (int m = 0; m < 4; ++m)
#pragma unroll
                for (int n = 0; n < 2; ++n) acc[a][b][m][n] = (f32x4){0.f, 0.f, 0.f, 0.f};
    bf16x8 At[4][2], B0[2][2], B1[2][2];
    const char* cA = (const char*)g.A + (size_t)(cur.pn / g.asel_div) * g.asel_stride * 2 + (size_t)cur.pm * tstepA; const char* cB = (const char*)g.Bt + (size_t)cur.pn * tstepB;
    PG8_STAGE(PG8_SB(0, 0), cB, voffB); PG8_STAGE(PG8_SA(0, 0), cA, voffA); PG8_STAGE(PG8_SB(0, 1), cB + hstepB, voffB); PG8_STAGE(PG8_SA(0, 1), cA + hstepA, voffA);
    if (wr == 1) PG8_BAR;
    PG8_WAIT_V(4); PG8_BAR;
    PG8_STAGE(PG8_SB(1, 0), cB + kstep, voffB); PG8_STAGE(PG8_SA(1, 0), cA + kstep, voffA); PG8_STAGE(PG8_SB(1, 1), cB + hstepB + kstep, voffB);
    PG8_WAIT_V(6); PG8_BAR;
    for (;;) {
        const bool has_next = S.next(ui + 1, nxt);
        const char* nA = has_next ? (const char*)g.A + (size_t)(nxt.pn / g.asel_div) * g.asel_stride * 2 + (size_t)nxt.pm * tstepA : cA; const char* nB = has_next ? (const char*)g.Bt + (size_t)nxt.pn * tstepB : cB;
        for (int t = 0; t < nt; t += 2) {
            const bool last = (t == nt - 2);
            const char* a1 = cA + (size_t)(t + 1) * kstep;
            const char* a2 = last ? nA : cA + (size_t)(t + 2) * kstep; const char* b2 = last ? nB : cB + (size_t)(t + 2) * kstep;
            const char* a3 = a2 + kstep; const char* b3 = b2 + kstep;
            PG8_LDB(B0, 0, 0); PG8_SCHED; PG8_LDA(At, 0, 0); PG8_STAGE(PG8_SA(1, 1), a1 + hstepA, voffA);
            PG8_WAIT_L(8); PG8_BAR; PG8_WAIT_L(0); PG8_MMA(0, 0, At, B0); PG8_BAR; PG8_SCHED;
            PG8_LDB(B1, 0, 1); PG8_STAGE(PG8_SB(0, 0), b2, voffB);
            PG8_BAR; PG8_WAIT_L(0); PG8_MMA(0, 1, At, B1); PG8_BAR;
            PG8_LDA(At, 0, 1); PG8_STAGE(PG8_SA(0, 0), a2, voffA);
            PG8_BAR; PG8_WAIT_L(0); PG8_MMA(1, 0, At, B0); PG8_BAR; PG8_SCHED;
            PG8_STAGE(PG8_SB(0, 1), b2 + hstepB, voffB);
            PG8_WAIT_V(6); PG8_BAR; PG8_MMA(1, 1, At, B1); PG8_BAR;
            PG8_LDB(B0, 1, 0); PG8_SCHED; PG8_LDA(At, 1, 0); PG8_STAGE(PG8_SA(0, 1), a2 + hstepA, voffA);
            PG8_WAIT_L(8); PG8_BAR; PG8_WAIT_L(0); PG8_MMA(0, 0, At, B0); PG8_BAR; PG8_SCHED;
            PG8_LDB(B1, 1, 1); PG8_STAGE(PG8_SB(1, 0), b3, voffB);
            PG8_BAR; PG8_WAIT_L(0); PG8_MMA(0, 1, At, B1); PG8_BAR;
            PG8_LDA(At, 1, 1); PG8_STAGE(PG8_SA(1, 0), a3, voffA);
            PG8_BAR; PG8_WAIT_L(0); PG8_MMA(1, 0, At, B0); PG8_BAR; PG8_SCHED;
            PG8_STAGE(PG8_SB(1, 1), b3 + hstepB, voffB);
            PG8_WAIT_V(6); PG8_BAR; PG8_MMA(1, 1, At, B1); PG8_BAR;
        }
        E(acc, cur, wr, wc, fr, fq);
        if (!has_next) break;
#pragma unroll
        for (int a = 0; a < 2; ++a)
#pragma unroll
            for (int b = 0; b < 2; ++b)
#pragma unroll
                for (int m = 0; m < 4; ++m)
#pragma unroll
                    for (int n = 0; n < 2; ++n) acc[a][b][m][n] = (f32x4){0.f, 0.f, 0.f, 0.f};
        cur = nxt; cA = nA; cB = nB; ++ui;
    }
    PG8_WAIT_V(0);
    if (wr == 0) PG8_BAR;
    PG8_BAR;
#undef PG8_SA
#undef PG8_SB
#undef PG8_STAGE
#undef PG8_LDA
#undef PG8_LDB
#undef PG8_MMA
#undef PG8_WAIT_V
#undef PG8_WAIT_L
#undef PG8_BAR
#undef PG8_SCHED
}
}
using pg8::Unit;

__device__ __forceinline__ float row_rstd(const float* ssq, int row) {
  const f32x4 a = *(const f32x4*)(ssq + (size_t)row * 4) + *(const f32x4*)(ssq + (size_t)(T + row) * 4) + *(const f32x4*)(ssq + (size_t)(2 * T + row) * 4) + *(const f32x4*)(ssq + (size_t)(3 * T + row) * 4);
  return rsqrtf((a[0] + a[1] + a[2] + a[3]) * (1.0f / 1024.0f) + EPS);
}

struct EpiProj {
  static constexpr bool PERM = true;
  bf16_t* proj; float* gs; const float* ssq; int smask;
  __device__ __forceinline__ void operator()(const f32x4 (&acc)[2][2][4][2], const Unit& u, int wr, int wc, int fr, int fq) const {
    const int row0 = u.pm * 256 + wr * 64 + fr, col0 = u.pn * 256 + wc * 32 + 8 * fq;
    const bool rot = (u.pn >= 12) && (u.pn < 16);
    float inv[8];
    if (rot) {
#pragma unroll
      for (int e = 0; e < 8; ++e) inv[e] = __builtin_amdgcn_exp2f(-(float)((wc * 32 + 8 * fq + e) & 63) * (13.287712379549449f / 64.0f)) * 0.15915494309189535f;
    }
    const float ksc = (u.pn >= 14) ? 0.08838834764831845f : 1.0f;
#pragma unroll
    for (int ai = 0; ai < 2; ++ai) {
      float rs[4];
#pragma unroll
      for (int m = 0; m < 4; ++m) rs[m] = row_rstd(ssq, row0 + ai * 128 + m * 16);
#pragma unroll
      for (int m = 0; m < 4; ++m) {
        const int row = row0 + ai * 128 + m * 16;
        if (rot) {
          const float pos = (float)(row & smask), sc = rs[m] * ksc;
          float o1[8], o2[8];
#pragma unroll
          for (int e = 0; e < 8; ++e) {
            float r = pos * inv[e]; r = r - floorf(r);
            const float sn = __builtin_amdgcn_sinf(r), cs = __builtin_amdgcn_cosf(r);
            const float t1 = acc[ai][0][m][e >> 2][e & 3] * sc, t2 = acc[ai][1][m][e >> 2][e & 3] * sc;
            o1[e] = t1 * cs - t2 * sn; o2[e] = t1 * sn + t2 * cs;
          }
          u32x4 w1, w2;
          w1.x = cvt_pk_bf16(o1[0], o1[1]); w1.y = cvt_pk_bf16(o1[2], o1[3]); w1.z = cvt_pk_bf16(o1[4], o1[5]); w1.w = cvt_pk_bf16(o1[6], o1[7]);
          w2.x = cvt_pk_bf16(o2[0], o2[1]); w2.y = cvt_pk_bf16(o2[2], o2[3]); w2.z = cvt_pk_bf16(o2[4], o2[5]); w2.w = cvt_pk_bf16(o2[6], o2[7]);
          *(u32x4*)(proj + (size_t)row * PLD + col0) = w1; *(u32x4*)(proj + (size_t)row * PLD + col0 + 128) = w2;
        } else {
#pragma unroll
          for (int bj = 0; bj < 2; ++bj) {
            const int c = col0 + bj * 128;
            f32x4 v0 = acc[ai][bj][m][0] * rs[m], v1 = acc[ai][bj][m][1] * rs[m];
            if (c < NPROJ) { u32x4 w; w.x = cvt_pk_bf16(v0[0], v0[1]); w.y = cvt_pk_bf16(v0[2], v0[3]); w.z = cvt_pk_bf16(v1[0], v1[1]); w.w = cvt_pk_bf16(v1[2], v1[3]);
              *(u32x4*)(proj + (size_t)row * PLD + c) = w; }
            if (c >= C_DT && c < C_DT + 32) { float* q = gs + (size_t)row * 32 + (c - C_DT); *(f32x4*)q = v0; *(f32x4*)(q + 4) = v1; }
            if (c >= C_MLG && c < C_MLG + 16) { float* q = gs + (size_t)T * 32 + (size_t)row * 16 + (c - C_MLG); *(f32x4*)q = v0; *(f32x4*)(q + 4) = v1; }
          }
        }
      }
    }
  }
};
struct EpiGate {
  static constexpr bool PERM = true;
  bf16_t* gate; const float* bias; const float* ssq;
  __device__ __forceinline__ void operator()(const f32x4 (&acc)[2][2][4][2], const Unit& u, int wr, int wc, int fr, int fq) const {
    const int row0 = u.pm * 256 + wr * 64 + fr, col0 = u.pn * 256 + wc * 32 + 8 * fq;
    float rs[2][4]; f32x4 bv[2][2];
#pragma unroll
    for (int bj = 0; bj < 2; ++bj) { bv[bj][0] = *(const f32x4*)(bias + col0 + bj * 128); bv[bj][1] = *(const f32x4*)(bias + col0 + bj * 128 + 4); }
#pragma unroll
    for (int ai = 0; ai < 2; ++ai)
#pragma unroll
      for (int m = 0; m < 4; ++m) rs[ai][m] = row_rstd(ssq, row0 + ai * 128 + m * 16);
#pragma unroll
    for (int ai = 0; ai < 2; ++ai)
#pragma unroll
      for (int m = 0; m < 4; ++m) {
        const int row = row0 + ai * 128 + m * 16;
#pragma unroll
        for (int bj = 0; bj < 2; ++bj) {
          const int c = col0 + bj * 128;
          f32x4 v0 = acc[ai][bj][m][0] * rs[ai][m] + bv[bj][0], v1 = acc[ai][bj][m][1] * rs[ai][m] + bv[bj][1];
#pragma unroll
          for (int j = 0; j < 4; ++j) { v0[j] = sigmoidf_(v0[j]); v1[j] = sigmoidf_(v1[j]); }
          u32x4 w; w.x = cvt_pk_bf16(v0[0], v0[1]); w.y = cvt_pk_bf16(v0[2], v0[3]); w.z = cvt_pk_bf16(v1[0], v1[1]); w.w = cvt_pk_bf16(v1[2], v1[3]);
          *(u32x4*)(gate + (size_t)row * 3072 + c) = w;
        }
      }
  }
};
struct EpiBranch {
  static constexpr bool PERM = true;
  const bf16_t* gate; bf16_t* merged;
  __device__ __forceinline__ void operator()(const f32x4 (&acc)[2][2][4][2], const Unit& u, int wr, int wc, int fr, int fq) const {
    const int br = u.pn >> 2;
    const int row0 = u.pm * 256 + wr * 64 + fr, col0 = u.pn * 256 + wc * 32 + 8 * fq, mcol0 = (u.pn & 3) * 256 + wc * 32 + 8 * fq;
#pragma unroll
    for (int ai = 0; ai < 2; ++ai) {
      u32x4 gw[4][2], mw[4][2];
#pragma unroll
      for (int m = 0; m < 4; ++m)
#pragma unroll
        for (int bj = 0; bj < 2; ++bj) {
          gw[m][bj] = *(const u32x4*)(gate + (size_t)(row0 + ai * 128 + m * 16) * 3072 + col0 + bj * 128);
          mw[m][bj] = br ? *(const u32x4*)(merged + (size_t)(row0 + ai * 128 + m * 16) * 1024 + mcol0 + bj * 128) : (u32x4){0u, 0u, 0u, 0u};
        }
#pragma unroll
      for (int m = 0; m < 4; ++m) {
        const int row = row0 + ai * 128 + m * 16;
#pragma unroll
        for (int bj = 0; bj < 2; ++bj) {
          const u32x4 g = gw[m][bj], o = mw[m][bj];
          const f32x4 a0 = acc[ai][bj][m][0], a1 = acc[ai][bj][m][1];
          u32x4 w;
          w.x = cvt_pk_bf16(a0[0] * bflo(g.x) + bflo(o.x), a0[1] * bfhi(g.x) + bfhi(o.x)); w.y = cvt_pk_bf16(a0[2] * bflo(g.y) + bflo(o.y), a0[3] * bfhi(g.y) + bfhi(o.y));
          w.z = cvt_pk_bf16(a1[0] * bflo(g.z) + bflo(o.z), a1[1] * bfhi(g.z) + bfhi(o.z)); w.w = cvt_pk_bf16(a1[2] * bflo(g.w) + bflo(o.w), a1[3] * bfhi(g.w) + bfhi(o.w));
          *(u32x4*)(merged + (size_t)row * 1024 + mcol0 + bj * 128) = w;
        }
      }
    }
  }
};
struct EpiRes {
  static constexpr bool PERM = false;
  bf16_t* xb; float* ssq;
  __device__ __forceinline__ void operator()(const f32x4 (&acc)[2][2][4][2], const Unit& u, int wr, int wc, int fr, int fq) const {
    const int row0 = u.pm * 256 + wr * 64 + fr, col0 = u.pn * 256 + wc * 32 + 4 * fq;
    u32x2 xw[2][4][2][2];
#pragma unroll
    for (int ai = 0; ai < 2; ++ai)
#pragma unroll
      for (int m = 0; m < 4; ++m)
#pragma unroll
        for (int bj = 0; bj < 2; ++bj)
#pragma unroll
          for (int n = 0; n < 2; ++n) xw[ai][m][bj][n] = *(const u32x2*)(xb + (size_t)(row0 + ai * 128 + m * 16) * 1024 + col0 + bj * 128 + n * 16);
#pragma unroll
    for (int ai = 0; ai < 2; ++ai)
#pragma unroll
      for (int m = 0; m < 4; ++m) {
        const int row = row0 + ai * 128 + m * 16; float sq = 0.f;
#pragma unroll
        for (int bj = 0; bj < 2; ++bj)
#pragma unroll
          for (int n = 0; n < 2; ++n) {
            const size_t off = (size_t)row * 1024 + col0 + bj * 128 + n * 16;
            const u32x2 o = xw[ai][m][bj][n];
            f32x4 v = acc[ai][bj][m][n];
            v[0] += bflo(o.x); v[1] += bfhi(o.x); v[2] += bflo(o.y); v[3] += bfhi(o.y);
            u32x2 w; w.x = cvt_pk_bf16(v[0], v[1]); w.y = cvt_pk_bf16(v[2], v[3]);
            *(u32x2*)(xb + off) = w;
            sq += (v[0] * v[0] + v[1] * v[1]) + (v[2] * v[2] + v[3] * v[3]);
          }
        sq += __shfl_xor(sq, 16); sq += __shfl_xor(sq, 32);
        if (fq == 0) ssq[((size_t)u.pn * T + row) * 4 + wc] = sq;
      }
  }
};
struct EpiFfn {
  static constexpr bool PERM = true;
  bf16_t* hid; const float* ssq;
  __device__ __forceinline__ void operator()(const f32x4 (&acc)[2][2][4][2], const Unit& u, int wr, int wc, int fr, int fq) const {
    const int row0 = u.pm * 256 + wr * 64 + fr, hc = u.pn * 128 + wc * 32 + 8 * fq;
    float rs[2][4];
#pragma unroll
    for (int ai = 0; ai < 2; ++ai)
#pragma unroll
      for (int m = 0; m < 4; ++m) rs[ai][m] = row_rstd(ssq, row0 + ai * 128 + m * 16);
#pragma unroll
    for (int ai = 0; ai < 2; ++ai)
#pragma unroll
      for (int m = 0; m < 4; ++m) {
        const int row = row0 + ai * 128 + m * 16; const float r = rs[ai][m];
        f32x4 o0, o1;
#pragma unroll
        for (int j = 0; j < 4; ++j) {
          o0[j] = siluf_(acc[ai][0][m][0][j] * r) * (acc[ai][1][m][0][j] * r);
          o1[j] = siluf_(acc[ai][0][m][1][j] * r) * (acc[ai][1][m][1][j] * r);
        }
        u32x4 w; w.x = cvt_pk_bf16(o0[0], o0[1]); w.y = cvt_pk_bf16(o0[2], o0[3]); w.z = cvt_pk_bf16(o1[0], o1[1]); w.w = cvt_pk_bf16(o1[2], o1[3]);
        *(u32x4*)(hid + (size_t)row * FF + hc) = w;
      }
  }
};

__device__ __forceinline__ int map_w1(int r) {
  if (r < 2560) return r;
  if (r < 3072) return r + 32;
  if (r < 4096) { const int isk = r >= 3584, q = r - (isk ? 3584 : 3072), t = q >> 8, w = q & 255, head = 2 * t + ((w >> 6) & 1), half = w >> 7, i = w & 63;
                  return (isk ? 6192 : 5680) + head * 128 + half * 64 + i; }
  if (r < 4608) return r - 4096 + 3104;
  if (r < 5632) return r - 4608 + 3616;
  if (r < 6656) return r - 5632 + 4640;
  if (r < 7680) return r - 6656 + 6704;
  if (r < 8704) return r - 7680 + 7728;
  if (r < 8736) return r - 8704 + 2560;
  if (r < 8752) return r - 8736 + 5664;
  return -1;
}
__device__ __forceinline__ void cvt_tile(LAS float* tl, const float* src, int sld, int k0, int n0, int nvalid, const float* scale,
                                         bf16_t* dst, int dld, int r0, int c0, int ncopy, bool w1map) {
  const int tid = opaque_tid();
#pragma unroll
  for (int it = 0; it < 2; ++it) {
    const int k = (tid >> 4) + it * 32, n4 = (tid & 15) * 4;
    f32x4 v = (f32x4){0.f, 0.f, 0.f, 0.f};
    const int sc_ = w1map ? map_w1(n0 + n4) : (n0 + n4 < nvalid ? n0 + n4 : -1);
    if (sc_ >= 0) v = *(const f32x4*)(src + (size_t)(k0 + k) * sld + sc_);
    const float s = scale ? scale[k0 + k] : 1.f;
    tl[k * 65 + n4 + 0] = v[0] * s; tl[k * 65 + n4 + 1] = v[1] * s; tl[k * 65 + n4 + 2] = v[2] * s; tl[k * 65 + n4 + 3] = v[3] * s;
  }
  __syncthreads();
  const int n = tid >> 3, k8 = (tid & 7) * 8;
  u32x4 w;
  w.x = cvt_pk_bf16(tl[(k8 + 0) * 65 + n], tl[(k8 + 1) * 65 + n]); w.y = cvt_pk_bf16(tl[(k8 + 2) * 65 + n], tl[(k8 + 3) * 65 + n]);
  w.z = cvt_pk_bf16(tl[(k8 + 4) * 65 + n], tl[(k8 + 5) * 65 + n]); w.w = cvt_pk_bf16(tl[(k8 + 6) * 65 + n], tl[(k8 + 7) * 65 + n]);
  for (int cp = 0; cp < ncopy; ++cp) *(u32x4*)(dst + (size_t)(r0 + n) * dld + c0 + cp * 1024 + k8) = w;
  __syncthreads();
}

__device__ void phase_convert(const Params& p, int layer, LAS unsigned char* lds, int parity, int first, int stride) {
  LAS float* tl = (LAS float*)lds;
  const float* gmix = p.in[2] + layer * 1024;
  const float* w_in = p.in[3] + (size_t)layer * 1024 * NPROJ;
  const float* w_gate = p.in[4] + (size_t)layer * 1024 * 3072;
  const float* w_branch = p.in[15] + (size_t)layer * 3 * 1024 * 1024;
  const float* w_out = p.in[16] + (size_t)layer * 1024 * 1024;
  const float* gffn = p.in[17] + layer * 1024;
  const float* w_fg = p.in[18] + (size_t)layer * 1024 * FF;
  const float* w_fu = p.in[19] + (size_t)layer * 1024 * FF;
  const float* w_fd = p.in[20] + (size_t)layer * FF * 1024;
  unsigned char* wb = p.ws + (parity ? WS_WB : 0);
  bf16_t* W1 = (bf16_t*)(wb + WS_W1); bf16_t* WG = (bf16_t*)(wb + WS_WG); bf16_t* W2 = (bf16_t*)(wb + WS_W2);
  bf16_t* W3 = (bf16_t*)(wb + WS_W3); bf16_t* W4 = (bf16_t*)(wb + WS_W4); bf16_t* W5 = (bf16_t*)(wb + WS_W5);
  for (int t = first; t < 6144; t += stride) {
    int i = t;
    const float* src; const float* scale = nullptr; bf16_t* dst; int sld, k0, n0, nvalid, dld, r0, ncopy = 1;
    if (i < 2240) { const int nt = i >> 4; k0 = (i & 15) * 64; n0 = nt * 64; src = w_in; sld = NPROJ; nvalid = NPROJ; scale = gmix; dst = W1; dld = 1024; r0 = n0; }
    else if ((i -= 2240) < 768) { const int nt = i >> 4; k0 = (i & 15) * 64; n0 = nt * 64; src = w_gate; sld = 3072; nvalid = 3072; scale = gmix; dst = WG; dld = 1024; r0 = n0; }
    else if ((i -= 768) < 768) { const int br = i >> 8, j = i & 255, nt = j >> 4; k0 = (j & 15) * 64; n0 = nt * 64; src = w_branch + (size_t)br * 1024 * 1024; sld = 1024; nvalid = 1024; dst = W2; dld = 1024; r0 = br * 1024 + n0; }
    else if ((i -= 768) < 256) { const int nt = i >> 4; k0 = (i & 15) * 64; n0 = nt * 64; src = w_out; sld = 1024; nvalid = 1024; dst = W3; dld = 1024; r0 = n0; }
    else if ((i -= 256) < 1408) { const int nt = i >> 4, pp = nt >> 2, half = (nt >> 1) & 1, sub = nt & 1; k0 = (i & 15) * 64; n0 = pp * 128 + sub * 64; src = half ? w_fu : w_fg; sld = FF; nvalid = FF; scale = gffn; dst = W4; dld = 1024; r0 = pp * 256 + half * 128 + sub * 64; }
    else { i -= 1408; const int nt = i / 44; k0 = (i % 44) * 64; n0 = nt * 64; src = w_fd; sld = 1024; nvalid = 1024; dst = W5; dld = FF; r0 = n0; }
    cvt_tile(tl, src, sld, k0, n0, nvalid, scale, dst, dld, r0, k0, ncopy, t < 2240);
  }
}

__device__ void phase_load_rows(const float* xin, bf16_t* xb, float* ssq) {
  const int tid_ = opaque_tid(); const int lane = tid_ & 63, wid = tid_ >> 6;
  for (int row = blockIdx.x * 8 + wid; row < T; row += gridDim.x * 8) {
    float sq = 0.f;
#pragma unroll
    for (int i = 0; i < 4; ++i) {
      const size_t off = (size_t)row * 1024 + i * 256 + lane * 4;
      const f32x4 v = *(const f32x4*)(xin + off);
      u32x2 w; w.x = cvt_pk_bf16(v[0], v[1]); w.y = cvt_pk_bf16(v[2], v[3]); *(u32x2*)(xb + off) = w;
      sq += (v[0] * v[0] + v[1] * v[1]) + (v[2] * v[2] + v[3] * v[3]);
    }
#pragma unroll
    for (int o = 1; o < 64; o <<= 1) sq += __shfl_xor(sq, o);
    if (lane < 16) ssq[((size_t)(lane >> 2) * T + row) * 4 + (lane & 3)] = lane == 0 ? sq : 0.f;
  }
}
__device__ void phase_final_norm(const bf16_t* xb, float* out, const float* ssq, const float* g) {
  const int tid_ = opaque_tid(); const int lane = tid_ & 63, wid = tid_ >> 6;
  for (int row = blockIdx.x * 8 + wid; row < T; row += gridDim.x * 8) {
    const float rs = row_rstd(ssq, row);
#pragma unroll
    for (int i = 0; i < 4; ++i) {
      const size_t off = (size_t)row * 1024 + i * 256 + lane * 4;
      const u32x2 w = *(const u32x2*)(xb + off); const f32x4 gg = *(const f32x4*)(g + i * 256 + lane * 4);
      const f32x4 v = (f32x4){bflo(w.x), bfhi(w.x), bflo(w.y), bfhi(w.y)};
      *(f32x4*)(out + off) = v * rs * gg;
    }
  }
}

__device__ void phase_conv(const bf16_t* proj, bf16_t* xc, const float* cw, const float* cb, int S) {
  const size_t total = (size_t)T * 192;
  const int tid_ = opaque_tid();
  for (size_t id = (size_t)blockIdx.x * 512 + tid_; id < total; id += (size_t)gridDim.x * 512) {
    const int t = (int)(id / 192), c8 = (int)(id % 192) * 8, pos = t % S;
    float a[8];
#pragma unroll
    for (int e = 0; e < 8; ++e) a[e] = cb[c8 + e];
#pragma unroll
    for (int tau = 0; tau < 4; ++tau) {
      const int pp = pos + tau - 2;
      if (pp >= 0 && pp < S) {
        const u32x4 v = *(const u32x4*)(proj + (size_t)(t + tau - 2) * PLD + C_XBC + c8);
        const float* w = cw + tau * 1536 + c8;
        a[0] += bflo(v.x) * w[0]; a[1] += bfhi(v.x) * w[1]; a[2] += bflo(v.y) * w[2]; a[3] += bfhi(v.y) * w[3];
        a[4] += bflo(v.z) * w[4]; a[5] += bfhi(v.z) * w[5]; a[6] += bflo(v.w) * w[6]; a[7] += bfhi(v.w) * w[7];
      }
    }
#pragma unroll
    for (int e = 0; e < 8; ++e) a[e] = siluf_(a[e]);
    u32x4 w; w.x = cvt_pk_bf16(a[0], a[1]); w.y = cvt_pk_bf16(a[2], a[3]); w.z = cvt_pk_bf16(a[4], a[5]); w.w = cvt_pk_bf16(a[6], a[7]);
    *(u32x4*)(xc + (size_t)t * 1536 + c8) = w;
  }
}

__device__ void phase_rope(bf16_t* proj, int S) {
  const int tid_ = opaque_tid();
  const size_t total = (size_t)T * 32;
  for (size_t id = (size_t)blockIdx.x * 512 + tid_; id < total; id += (size_t)gridDim.x * 512) {
    const int t = (int)(id >> 5), hd = (int)(id >> 3) & 3, ch = (int)id & 7;
    bf16_t* src = proj + (size_t)t * PLD + hd * 128 + ch * 8;
    const u32x4 q1 = *(const u32x4*)(src + C_RTQ), q2 = *(const u32x4*)(src + C_RTQ + 64), k1 = *(const u32x4*)(src + C_RTK), k2 = *(const u32x4*)(src + C_RTK + 64);
    const float pos = (float)(t % S);
    float cs[8], sn[8];
#pragma unroll
    for (int e = 0; e < 8; ++e) {
      const float inv = __builtin_amdgcn_exp2f(-(float)(ch * 8 + e) * (13.287712379549449f / 64.0f));
      float r = pos * inv * 0.15915494309189535f; r = r - floorf(r);
      sn[e] = __builtin_amdgcn_sinf(r); cs[e] = __builtin_amdgcn_cosf(r);
    }
    const float ksc = 0.08838834764831845f;
    const unsigned qa[4] = {q1.x, q1.y, q1.z, q1.w}, qb[4] = {q2.x, q2.y, q2.z, q2.w}, ka[4] = {k1.x, k1.y, k1.z, k1.w}, kb[4] = {k2.x, k2.y, k2.z, k2.w};
    unsigned oq1[4], oq2[4], ok1[4], ok2[4];
#pragma unroll
    for (int w = 0; w < 4; ++w) {
      const float a0 = bflo(qa[w]), a1 = bfhi(qa[w]), b0 = bflo(qb[w]), b1 = bfhi(qb[w]);
      oq1[w] = cvt_pk_bf16(a0 * cs[2 * w] - b0 * sn[2 * w], a1 * cs[2 * w + 1] - b1 * sn[2 * w + 1]);
      oq2[w] = cvt_pk_bf16(a0 * sn[2 * w] + b0 * cs[2 * w], a1 * sn[2 * w + 1] + b1 * cs[2 * w + 1]);
      const float e0 = bflo(ka[w]) * ksc, e1 = bfhi(ka[w]) * ksc, g0 = bflo(kb[w]) * ksc, g1 = bfhi(kb[w]) * ksc;
      ok1[w] = cvt_pk_bf16(e0 * cs[2 * w] - g0 * sn[2 * w], e1 * cs[2 * w + 1] - g1 * sn[2 * w + 1]);
      ok2[w] = cvt_pk_bf16(e0 * sn[2 * w] + g0 * cs[2 * w], e1 * sn[2 * w + 1] + g1 * cs[2 * w + 1]);
    }
    *(u32x4*)(src + C_RTQ) = (u32x4){oq1[0], oq1[1], oq1[2], oq1[3]};
    *(u32x4*)(src + C_RTQ + 64) = (u32x4){oq2[0], oq2[1], oq2[2], oq2[3]};
    *(u32x4*)(src + C_RTK) = (u32x4){ok1[0], ok1[1], ok1[2], ok1[3]};
    *(u32x4*)(src + C_RTK + 64) = (u32x4){ok2[0], ok2[1], ok2[2], ok2[3]};
  }
}

constexpr int MXP = 272;
constexpr int MX_Q = 0, MX_K = 34816, MX_KT = 69632, MX_VT = 104448, MX_HT = 121856, MX_V = 139264, MX_N = 155648, MX_VEC = 155904, MX_END = MX_VEC + 7 * 512 + 64;
constexpr int LDS_XB = MX_END > pg8::STAGE_BYTES ? MX_END : pg8::STAGE_BYTES;
constexpr int LDS_BYTES = LDS_XB + 16;

__device__ __forceinline__ int swz(int row, int col) { return row * MXP + col * 2; }
__device__ __forceinline__ bf16x8 ldfrag(LAS const unsigned char* base, int row0, int ks, int lane) {
  const int row = row0 + (lane & 31);
  return *(LAS const bf16x8*)(base + row * MXP + (lane >> 5) * 16 + ks * 32);
}
__device__ __forceinline__ u32x4 scale_pk(u32x4 v, float s) {
  u32x4 w; w.x = cvt_pk_bf16(bflo(v.x) * s, bfhi(v.x) * s); w.y = cvt_pk_bf16(bflo(v.y) * s, bfhi(v.y) * s);
  w.z = cvt_pk_bf16(bflo(v.z) * s, bfhi(v.z) * s); w.w = cvt_pk_bf16(bflo(v.w) * s, bfhi(v.w) * s); return w;
}

template <int BR, bool DEN>
__device__ void mixer_item(const Params& p, LAS unsigned char* lds, int layer, int S, int seq, int dir, int ht) {
  const int tid = opaque_tid(), wid = __builtin_amdgcn_readfirstlane(tid >> 6), lane = tid & 63, rb = wid >> 1, cb = wid & 1;
  const bf16_t* proj = (const bf16_t*)(p.ws + WS_PROJ);
  const bf16_t* xc = (const bf16_t*)(p.ws + WS_XC);
  const float* gs = (const float*)(p.ws + WS_GS);
  bf16_t* yout = (bf16_t*)(p.ws + (dir ? WS_YB : WS_YF));
  LAS float* vC = (LAS float*)(lds + MX_VEC); LAS float* vMu = vC + 128; LAS float* vW = vC + 256; LAS float* vR = vC + 384; LAS float* vCl = vC + 512; LAS float* vVs = vC + 640; LAS float* sc = vC + 896;
  constexpr bool STAB = (BR == 1);
  int hd, vt, ocol;
  if (BR == 0) { hd = ht; vt = 0; ocol = ht * 64; } else if (DEN) { hd = ht; vt = 0; ocol = 0; } else { hd = ht >> 2; vt = ht & 3; ocol = (BR == 1 ? 1024 : 2048) + hd * 256 + vt * 64; }
  float cst_a = 0.f, cst_b = 0.f, cst_c = 0.f;
  if (BR == 0) { cst_a = -expf(p.in[8][layer * 32 + dir * 16 + hd]); cst_b = p.in[9][layer * 32 + dir * 16 + hd]; }
  if (BR == 1) { cst_b = p.in[12][layer * 16 + (2 * dir) * 4 + hd]; cst_c = p.in[12][layer * 16 + (2 * dir + 1) * 4 + hd]; }
  if (BR == 2) { cst_a = logf(1.0f - exp2f(-5.0f - (4.0f / 3.0f) * (float)hd)); }
  const int nc = S / 128;
  const int seqbase = seq * S;
  f32x16 Hacc;
#pragma unroll
  for (int j = 0; j < 16; ++j) Hacc[j] = 0.f;
  float m_st = 0.f;
  { unsigned z0 = 0u; asm volatile("" : "+v"(z0)); const u32x4 zv = (u32x4){z0, z0, z0, z0};
    for (int i = tid; i < 64 * MXP / 16; i += 512) *(LAS u32x4*)(lds + MX_HT + i * 16) = zv;
    if (tid < 16) *(LAS u32x4*)(lds + MX_N + tid * 16) = zv; }

  u32x4 ra[8], rv[2]; float rg[4] = {0.f, 0.f, 0.f, 0.f};
#define MX_ISSUE_LOADS(ci_) do { \
    const int tk_ = seqbase + (ci_) * 128; \
    { \
      _Pragma("unroll") for (int it = 0; it < 4; ++it) { const int id = it * 512 + tid, row = id >> 4, ch = id & 15; \
        if (BR == 1) { const bf16_t* src = proj + (size_t)(tk_ + row) * PLD + hd * 128 + ch * 8; ra[it] = *(const u32x4*)(src + C_MLQ); ra[4 + it] = *(const u32x4*)(src + C_MLK); } \
        else if (BR == 2) { const bf16_t* src = proj + (size_t)(tk_ + row) * PLD + (hd >> 1) * 256 + (ch >> 3) * 128 + (hd & 1) * 64 + (ch & 7) * 8; ra[it] = *(const u32x4*)(src + C_RTQ); ra[4 + it] = *(const u32x4*)(src + C_RTK); } \
        else { const bf16_t* src = xc + (size_t)(tk_ + row) * 1536 + (hd >> 3) * 128 + ch * 8; ra[it] = *(const u32x4*)(src + 1280); ra[4 + it] = *(const u32x4*)(src + 1024); } } \
    } \
    _Pragma("unroll") for (int it = 0; it < 2; ++it) { const int id = it * 512 + tid, row = id >> 3, ch = id & 7; \
      if (DEN) rv[it] = (u32x4){0x3F803F80u, 0x3F803F80u, 0x3F803F80u, 0x3F803F80u}; \
      else if (BR == 0) rv[it] = *(const u32x4*)(xc + (size_t)(tk_ + row) * 1536 + hd * 64 + ch * 8); \
      else rv[it] = *(const u32x4*)(proj + (size_t)(tk_ + row) * PLD + (BR == 1 ? C_MLV : C_RTV) + hd * 256 + vt * 64 + ch * 8); } \
    if (wid == 0 && BR != 2) { const int q0_ = dir ? 127 - 2 * lane : 2 * lane, q1_ = dir ? 126 - 2 * lane : 2 * lane + 1; \
      if (BR == 0) { rg[0] = gs[(size_t)(tk_ + q0_) * 32 + dir * 16 + hd]; rg[1] = gs[(size_t)(tk_ + q1_) * 32 + dir * 16 + hd]; } \
      else { const float* gg = gs + (size_t)T * 32; rg[0] = gg[(size_t)(tk_ + q0_) * 16 + (2 * dir + 1) * 4 + hd]; rg[1] = gg[(size_t)(tk_ + q1_) * 16 + (2 * dir + 1) * 4 + hd]; \
        rg[2] = gg[(size_t)(tk_ + q0_) * 16 + (2 * dir) * 4 + hd]; rg[3] = gg[(size_t)(tk_ + q1_) * 16 + (2 * dir) * 4 + hd]; } } \
  } while (0)
  MX_ISSUE_LOADS(dir ? nc - 1 : 0);

  for (int c = 0; c < nc; ++c) {
    const int ci = dir ? nc - 1 - c : c;
    const int tok0 = seqbase + ci * 128;
    if (wid == 0) {
      const int j0 = 2 * lane, j1 = j0 + 1;
      const int p0 = dir ? 127 - j0 : j0, p1 = dir ? 127 - j1 : j1;
      float l0, l1, b0 = 0.f, b1 = 0.f, d0 = 1.f, d1 = 1.f;
      if (BR == 0) {
        d0 = softplusf_(rg[0] + cst_b); d1 = softplusf_(rg[1] + cst_b);
        l0 = d0 * cst_a; l1 = d1 * cst_a;
      } else if (BR == 1) {
        l0 = -softplusf_(-(rg[0] + cst_c)); l1 = -softplusf_(-(rg[1] + cst_c));
        b0 = rg[2] + cst_b; b1 = rg[3] + cst_b;
      } else { l0 = cst_a; l1 = cst_a; }
      float run = l0 + l1;
#pragma unroll
      for (int o = 1; o < 64; o <<= 1) { const float t = __shfl_up(run, o); if (lane >= o) run += t; }
      const float A1 = run, A0 = run - l1;
      const float A_end = __shfl(A1, 63);
      const float c0 = b0 - A0, c1 = b1 - A1;
      float mu0, mu1, mu_end;
      if (STAB) {
        float rm = fmaxf(c0, c1);
#pragma unroll
        for (int o = 1; o < 64; o <<= 1) { const float t = __shfl_up(rm, o); if (lane >= o) rm = fmaxf(rm, t); }
        const float ex = __shfl_up(rm, 1);
        const float pm0 = lane > 0 ? fmaxf(ex, c0) : c0, pm1 = rm;
        mu0 = fmaxf(m_st, pm0); mu1 = fmaxf(m_st, pm1); mu_end = fmaxf(m_st, __shfl(pm1, 63));
      } else { mu0 = -A0; mu1 = -A1; mu_end = -A_end; }
      vC[p0] = c0; vC[p1] = c1; vMu[p0] = mu0; vMu[p1] = mu1;
      vW[p0] = __expf(c0 - mu_end); vW[p1] = __expf(c1 - mu_end);
      vR[p0] = __expf(m_st - mu0); vR[p1] = __expf(m_st - mu1);
      vCl[p0] = STAB ? __expf(-A0 - mu0) : 0.f; vCl[p1] = STAB ? __expf(-A1 - mu1) : 0.f;
      vVs[p0] = d0; vVs[p1] = d1;
      if (lane == 0) sc[0] = __expf(m_st - mu_end);
      m_st = STAB ? A_end + mu_end : 0.f;
    }
    {
#pragma unroll
      for (int it = 0; it < 4; ++it) {
        const int id = it * 512 + tid, row = id >> 4, ch = id & 15;
        *(LAS u32x4*)(lds + MX_Q + swz(row, ch * 8)) = BR == 1 ? scale_pk(ra[it], 0.08838834764831845f) : ra[it];
        *(LAS u32x4*)(lds + MX_K + swz(row, ch * 8)) = ra[4 + it];
      }
    }
#pragma unroll
    for (int it = 0; it < 2; ++it) {
      const int id = it * 512 + tid, row = id >> 3, ch = id & 7;
      *(LAS u32x4*)(lds + MX_V + row * 128 + ch * 16) = rv[it];
    }
    __syncthreads();
    {
      const int dk = tid & 127, sg = tid >> 7, dv = tid & 63, sv = tid >> 6;
      unsigned short kr[32], vr[16];
      f32x4 w4[8], vs4[4];
#pragma unroll
      for (int i = 0; i < 32; ++i) kr[i] = *(LAS const bf16_t*)(lds + MX_K + swz(sg * 32 + i, dk));
#pragma unroll
      for (int i = 0; i < 16; ++i) vr[i] = *(LAS const bf16_t*)(lds + MX_V + (sv * 16 + i) * 128 + dv * 2);
#pragma unroll
      for (int i = 0; i < 8; ++i) w4[i] = *(LAS const f32x4*)(vW + sg * 32 + i * 4);
      if (BR == 0) {
#pragma unroll
        for (int i = 0; i < 4; ++i) vs4[i] = *(LAS const f32x4*)(vVs + sv * 16 + i * 4);
      }
      __builtin_amdgcn_sched_barrier(0);
#pragma unroll
      for (int s8 = 0; s8 < 4; ++s8) {
        float f[8];
#pragma unroll
        for (int e = 0; e < 8; ++e) f[e] = bf2f(kr[s8 * 8 + e]) * w4[s8 * 2 + (e >> 2)][e & 3];
        u32x4 w; w.x = cvt_pk_bf16(f[0], f[1]); w.y = cvt_pk_bf16(f[2], f[3]); w.z = cvt_pk_bf16(f[4], f[5]); w.w = cvt_pk_bf16(f[6], f[7]);
        *(LAS u32x4*)(lds + MX_KT + swz(dk, sg * 32 + s8 * 8)) = w;
      }
#pragma unroll
      for (int s8 = 0; s8 < 2; ++s8) {
        float f[8];
#pragma unroll
        for (int e = 0; e < 8; ++e) { f[e] = bf2f(vr[s8 * 8 + e]); if (BR == 0) f[e] *= vs4[s8 * 2 + (e >> 2)][e & 3]; }
        u32x4 w; w.x = cvt_pk_bf16(f[0], f[1]); w.y = cvt_pk_bf16(f[2], f[3]); w.z = cvt_pk_bf16(f[4], f[5]); w.w = cvt_pk_bf16(f[6], f[7]);
        *(LAS u32x4*)(lds + MX_VT + swz(dv, sv * 16 + s8 * 8)) = w;
      }
    }
    __syncthreads();
    f32x16 S0, S1, QH;
#pragma unroll
    for (int j = 0; j < 16; ++j) { S0[j] = 0.f; S1[j] = 0.f; QH[j] = 0.f; }
    {
      const float dec = sc[0];
#pragma unroll
      for (int j = 0; j < 16; ++j) { Hacc[j] *= dec; }
      bf16x8 fa[2], fb0[2], fb1[2], fhb[2], fka[2], fvb[2];
      fa[0] = ldfrag(lds + MX_Q, 32 * rb, 0, lane); fb0[0] = ldfrag(lds + MX_K, 64 * cb, 0, lane); fb1[0] = ldfrag(lds + MX_K, 64 * cb + 32, 0, lane);
      fhb[0] = ldfrag(lds + MX_HT, 32 * cb, 0, lane); fka[0] = ldfrag(lds + MX_KT, 32 * rb, 0, lane); fvb[0] = ldfrag(lds + MX_VT, 32 * cb, 0, lane);
#pragma unroll
      for (int ks = 0; ks < 8; ++ks) {
        const int cur = ks & 1, nxt = cur ^ 1;
        if (ks < 7) {
          fa[nxt] = ldfrag(lds + MX_Q, 32 * rb, ks + 1, lane); fb0[nxt] = ldfrag(lds + MX_K, 64 * cb, ks + 1, lane); fb1[nxt] = ldfrag(lds + MX_K, 64 * cb + 32, ks + 1, lane);
          fhb[nxt] = ldfrag(lds + MX_HT, 32 * cb, ks + 1, lane); fka[nxt] = ldfrag(lds + MX_KT, 32 * rb, ks + 1, lane); fvb[nxt] = ldfrag(lds + MX_VT, 32 * cb, ks + 1, lane);
        }
        __builtin_amdgcn_sched_barrier(0);
        S0 = __builtin_amdgcn_mfma_f32_32x32x16_bf16(fa[cur], fb0[cur], S0, 0, 0, 0);
        S1 = __builtin_amdgcn_mfma_f32_32x32x16_bf16(fa[cur], fb1[cur], S1, 0, 0, 0);
        QH = __builtin_amdgcn_mfma_f32_32x32x16_bf16(fa[cur], fhb[cur], QH, 0, 0, 0);
        Hacc = __builtin_amdgcn_mfma_f32_32x32x16_bf16(fka[cur], fvb[cur], Hacc, 0, 0, 0);
        __builtin_amdgcn_sched_barrier(0);
      }
    }
    __syncthreads();
    { const int cn = c + 1 < nc ? c + 1 : c; MX_ISSUE_LOADS(dir ? nc - 1 - cn : cn); }
    {
      const int sA = 64 * cb + (lane & 31), sB = sA + 32;
      const float cA = vC[sA], cB = vC[sB];
      float mu16[16];
#pragma unroll
      for (int j = 0; j < 16; ++j) mu16[j] = vMu[32 * rb + 8 * (j >> 2) + 4 * (lane >> 5) + (j & 3)];
      __builtin_amdgcn_sched_barrier(0);
#pragma unroll
      for (int j = 0; j < 16; ++j) {
        const int t = 32 * rb + 8 * (j >> 2) + 4 * (lane >> 5) + (j & 3);
        const float mu = mu16[j];
        bool okA, okB;
        if (dir == 0) { okA = sA <= t; okB = sB <= t; } else if (BR == 2) { okA = sA > t; okB = sB > t; } else { okA = sA >= t; okB = sB >= t; }
        const float pa = okA ? S0[j] * __expf(cA - mu) : 0.f, pb = okB ? S1[j] * __expf(cB - mu) : 0.f;
        *(LAS bf16_t*)(lds + MX_Q + swz(t, sA)) = f2bf(pa);
        *(LAS bf16_t*)(lds + MX_Q + swz(t, sB)) = f2bf(pb);
      }
#pragma unroll
      for (int g4 = 0; g4 < 4; ++g4) {
        const int dk0 = 32 * rb + 8 * g4 + 4 * (lane >> 5), dvr = 32 * cb + (lane & 31);
        u32x2 w; w.x = cvt_pk_bf16(Hacc[4 * g4 + 0], Hacc[4 * g4 + 1]); w.y = cvt_pk_bf16(Hacc[4 * g4 + 2], Hacc[4 * g4 + 3]);
        *(LAS u32x2*)(lds + MX_HT + swz(dvr, dk0)) = w;
      }
    }
    __syncthreads();
    {
      float rsc[16];
#pragma unroll
      for (int j = 0; j < 16; ++j) { const int t = 32 * rb + 8 * (j >> 2) + 4 * (lane >> 5) + (j & 3); rsc[j] = vR[t]; QH[j] *= rsc[j]; }
      bf16x8 pa[2], pv[2];
      pa[0] = ldfrag(lds + MX_Q, 32 * rb, 0, lane); pv[0] = ldfrag(lds + MX_VT, 32 * cb, 0, lane);
#pragma unroll
      for (int ks = 0; ks < 8; ++ks) {
        const int cur = ks & 1, nxt = cur ^ 1;
        if (ks < 7) { pa[nxt] = ldfrag(lds + MX_Q, 32 * rb, ks + 1, lane); pv[nxt] = ldfrag(lds + MX_VT, 32 * cb, ks + 1, lane); }
        __builtin_amdgcn_sched_barrier(0);
        QH = __builtin_amdgcn_mfma_f32_32x32x16_bf16(pa[cur], pv[cur], QH, 0, 0, 0);
        __builtin_amdgcn_sched_barrier(0);
      }
#pragma unroll
      for (int j = 0; j < 16; ++j) {
        const int t = 32 * rb + 8 * (j >> 2) + 4 * (lane >> 5) + (j & 3);
        const float y = QH[j];
        if (DEN) { if (cb == 0 && (lane & 31) == 0) { float* dp = (float*)(p.ws + WS_DEN) + (((size_t)(dir * 4 + hd) * T) + tok0 + t) * 2; dp[0] = y; dp[1] = vCl[t]; } }
        else yout[(size_t)(tok0 + t) * 3072 + ocol + 32 * cb + (lane & 31)] = f2bf(y);
      }
    }
    __syncthreads();
  }
}

#undef MX_ISSUE_LOADS
__device__ void phase_mixer(const Params& p, LAS unsigned char* lds, int layer, int S, int conv_layer, int conv_parity) {
  const int nseq = T / S, nitems = nseq * 2 * 52;
  for (int it = blockIdx.x; it < nitems; it += gridDim.x) {
    const int ht_ord = it / (nseq * 2), rem = it % (nseq * 2), seq = rem >> 1, dir = rem & 1;
#ifdef ONLY_BR
    mixer_item<ONLY_BR, false>(p, lds, layer, S, seq, dir, ht_ord & 15);
#else
    if (ht_ord < 16) mixer_item<1, false>(p, lds, layer, S, seq, dir, ht_ord);
    else if (ht_ord < 20) mixer_item<1, true>(p, lds, layer, S, seq, dir, ht_ord - 16);
    else if (ht_ord < 36) mixer_item<2, false>(p, lds, layer, S, seq, dir, ht_ord - 20);
    else mixer_item<0, false>(p, lds, layer, S, seq, dir, ht_ord - 36);
#endif
  }
  if (conv_layer >= 0) {
    const int G = gridDim.x, rem = nitems % G, nconv = G - rem;
    if ((int)blockIdx.x >= rem) phase_convert(p, conv_layer, lds, conv_parity, (int)blockIdx.x - rem, nconv);
  }
}

__device__ void phase_post(const Params& p, int layer) {
  const int tid_ = opaque_tid(); const int lane = tid_ & 63, wid = tid_ >> 6;
  const bf16_t* proj = (const bf16_t*)(p.ws + WS_PROJ); const bf16_t* xc = (const bf16_t*)(p.ws + WS_XC);
  const bf16_t* yf = (const bf16_t*)(p.ws + WS_YF); const bf16_t* yb = (const bf16_t*)(p.ws + WS_YB);
  const float* den = (const float*)(p.ws + WS_DEN);
  bf16_t* act = (bf16_t*)(p.ws + WS_PROJ) + ACT_COL;
  const float* dsk = p.in[10] + layer * 16; const float* g_ssd = p.in[11] + layer * 1024; const float* g_ml = p.in[13] + layer * 1024; const float* g_rt = p.in[14] + layer * 1024;
  for (int row = blockIdx.x * 8 + wid; row < T; row += gridDim.x * 8) {
    u32x4 wf[3][2], wb[3][2], wg[3][2], wx[2]; float dn[2][4];
#pragma unroll
    for (int br = 0; br < 3; ++br)
#pragma unroll
      for (int k = 0; k < 2; ++k) {
        const int c = br * 1024 + k * 512 + lane * 8;
        wf[br][k] = *(const u32x4*)(yf + (size_t)row * 3072 + c); wb[br][k] = *(const u32x4*)(yb + (size_t)row * 3072 + c);
        const int gcol = (br == 0 ? C_Z : (br == 1 ? C_MLO : C_RTG)) + k * 512 + lane * 8;
        wg[br][k] = *(const u32x4*)(proj + (size_t)row * PLD + gcol);
      }
#pragma unroll
    for (int k = 0; k < 2; ++k) {
      wx[k] = *(const u32x4*)(xc + (size_t)row * 1536 + k * 512 + lane * 8);
      const int h = k * 2 + (lane >> 5);
      const float* df = den + (((size_t)(0 * 4 + h) * T) + row) * 2; const float* db = den + (((size_t)(1 * 4 + h) * T) + row) * 2;
      dn[k][0] = df[0]; dn[k][1] = df[1]; dn[k][2] = db[0]; dn[k][3] = db[1];
    }
#pragma unroll
    for (int br = 0; br < 3; ++br) {
      float y[2][8], gt[2][8], sq[2];
#pragma unroll
      for (int k = 0; k < 2; ++k) {
        const unsigned aa[4] = {wf[br][k].x, wf[br][k].y, wf[br][k].z, wf[br][k].w}, bb[4] = {wb[br][k].x, wb[br][k].y, wb[br][k].z, wb[br][k].w}, gg[4] = {wg[br][k].x, wg[br][k].y, wg[br][k].z, wg[br][k].w};
        float nf = 1.f, nb = 1.f;
        if (br == 1) { nf = 1.0f / fmaxf(fabsf(dn[k][0]), dn[k][1]); nb = 1.0f / fmaxf(fabsf(dn[k][2]), dn[k][3]); }
#pragma unroll
        for (int w = 0; w < 4; ++w) {
          y[k][2 * w] = bflo(aa[w]) * nf + bflo(bb[w]) * nb; y[k][2 * w + 1] = bfhi(aa[w]) * nf + bfhi(bb[w]) * nb;
          gt[k][2 * w] = bflo(gg[w]); gt[k][2 * w + 1] = bfhi(gg[w]);
        }
        if (br == 0) {
          const float dd = dsk[k * 8 + (lane >> 3)];
          const unsigned xx[4] = {wx[k].x, wx[k].y, wx[k].z, wx[k].w};
#pragma unroll
          for (int w = 0; w < 4; ++w) { y[k][2 * w] += bflo(xx[w]) * dd; y[k][2 * w + 1] += bfhi(xx[w]) * dd; }
#pragma unroll
          for (int e = 0; e < 8; ++e) y[k][e] *= siluf_(gt[k][e]);
        }
        float q = 0.f;
#pragma unroll
        for (int e = 0; e < 8; ++e) q += y[k][e] * y[k][e];
        q += __shfl_xor(q, 1); q += __shfl_xor(q, 2); q += __shfl_xor(q, 4); q += __shfl_xor(q, 8); q += __shfl_xor(q, 16);
        sq[k] = q;
      }
      float rs[2];
      if (br == 0) { float t = sq[0] + sq[1]; t += __shfl_xor(t, 32); rs[0] = rs[1] = rsqrtf(t * (1.0f / 1024.0f) + EPS); }
      else { rs[0] = rsqrtf(sq[0] * (1.0f / 256.0f) + EPS); rs[1] = rsqrtf(sq[1] * (1.0f / 256.0f) + EPS); }
#pragma unroll
      for (int k = 0; k < 2; ++k) {
        const float* gn = (br == 0 ? g_ssd : (br == 1 ? g_ml : g_rt)) + k * 512 + lane * 8;
        const f32x4 g0 = *(const f32x4*)gn, g1 = *(const f32x4*)(gn + 4);
        unsigned o[4];
#pragma unroll
        for (int e = 0; e < 8; e += 2) {
          float v0 = y[k][e] * rs[k] * (e < 4 ? g0[e] : g1[e - 4]), v1 = y[k][e + 1] * rs[k] * (e < 4 ? g0[e + 1] : g1[e - 3]);
          if (br == 1) { v0 *= sigmoidf_(gt[k][e]); v1 *= sigmoidf_(gt[k][e + 1]); }
          if (br == 2) { v0 *= siluf_(gt[k][e]); v1 *= siluf_(gt[k][e + 1]); }
          o[e >> 1] = cvt_pk_bf16(v0, v1);
        }
        *(u32x4*)(act + (size_t)row * PLD + br * 1024 + k * 512 + lane * 8) = (u32x4){o[0], o[1], o[2], o[3]};
      }
    }
  }
}

#ifndef PH_MASK
#define PH_MASK 0xFFFF
#endif
#ifndef REP_SYNC
#define REP_SYNC 1
#endif
#ifndef REP_MIX
#define REP_MIX 1
#endif
#ifndef REP_G1
#define REP_G1 1
#endif
#ifndef REP_MISC
#define REP_MISC 1
#endif
#ifndef REP_G2
#define REP_G2 1
#endif
#ifndef REP_G4
#define REP_G4 1
#endif
#define XB_TMO      128
#define XB_XCNT(j)  (256  + 64 * (j))
#define XB_XSUB(j)  (1280 + 64 * (j))
#define XB_XGEN(j)  (2304 + 64 * (j))
#define XB_TOP      3328
#define XB_TOPGEN   3392
#define XCD_BAR_WORDS 3456
#define XB_SPIN_CAP (1u << 22)

__device__ __forceinline__ unsigned xb_ld(unsigned* p)              { return __hip_atomic_load(p, __ATOMIC_RELAXED, __HIP_MEMORY_SCOPE_AGENT); }
__device__ __forceinline__ unsigned xb_add(unsigned* p, unsigned v) { return __hip_atomic_fetch_add(p, v, __ATOMIC_RELAXED, __HIP_MEMORY_SCOPE_AGENT); }
__device__ __forceinline__ unsigned xb_xcc_id() { return (unsigned)__builtin_amdgcn_s_getreg((3 << 11) | 20) & 0xFu; }
#define XB_SPIN(cond, bar) do { unsigned _sp = 0; while (cond) { __builtin_amdgcn_s_sleep(1); \
    if ((++_sp & 255u) == 0u) { if (xb_ld(&(bar)[XB_TMO])) break; if (_sp > XB_SPIN_CAP) { atomicAdd(&(bar)[XB_TMO], 1u); break; } } } } while (0)
struct XcdBarrier { unsigned* bar; unsigned x; volatile LAS unsigned* st; };
__device__ __forceinline__ XcdBarrier xcd_barrier_post(unsigned* bar, volatile LAS unsigned* st) {
    XcdBarrier b; b.bar = bar; b.x = xb_xcc_id(); b.st = st;
    if (threadIdx.x == 0) (void)xb_add(&bar[XB_XCNT(b.x)], 1u);
    return b;
}
__device__ __forceinline__ void xcd_barrier_complete(unsigned* bar, unsigned x, unsigned& nloc, unsigned& nx) {
    const unsigned G = gridDim.x * gridDim.y * gridDim.z;
    unsigned sum, cnt, mine, sp = 0u;
    for (;;) {
        sum = 0u; cnt = 0u; mine = 0u;
#pragma unroll
        for (unsigned j = 0; j < 16; ++j) { const unsigned c = xb_ld(&bar[XB_XCNT(j)]); sum += c; cnt += (c > 0u) ? 1u : 0u; mine = (j == x) ? c : mine; }
        if (sum == G) break;
        __builtin_amdgcn_s_sleep(1);
        if ((++sp & 255u) == 0u) { if (xb_ld(&bar[XB_TMO])) break; if (sp > XB_SPIN_CAP) { atomicAdd(&bar[XB_TMO], 1u); break; } }
    }
    nloc = mine > 0u ? mine : 1u; nx = cnt > 0u ? cnt : 1u;
}
__device__ __forceinline__ void xcd_barrier(const XcdBarrier& b) {
    asm volatile("s_waitcnt vmcnt(0)" ::: "memory");
    __syncthreads();
    if (threadIdx.x == 0) {
        unsigned* bar = b.bar;
        __builtin_amdgcn_s_waitcnt(0);
        unsigned nloc = b.st[0], nx = b.st[1];
        if (nloc == 0u) { xcd_barrier_complete(bar, b.x, nloc, nx); b.st[0] = nloc; b.st[1] = nx; }
        const unsigned old = xb_add(&bar[XB_XSUB(b.x)], 1u);
        const unsigned gen = old / nloc;
        if (old + 1u == (gen + 1u) * nloc) {
            __builtin_amdgcn_fence(__ATOMIC_RELEASE, "agent");
            asm volatile("s_waitcnt vmcnt(0)" ::: "memory");
            const unsigned og = xb_add(&bar[XB_TOP], 1u);
            const unsigned tg = og / nx;
            if (og + 1u == (tg + 1u) * nx) xb_add(&bar[XB_TOPGEN], 1u);
            else XB_SPIN(xb_ld(&bar[XB_TOPGEN]) == tg, bar);
            __builtin_amdgcn_fence(__ATOMIC_ACQUIRE, "agent");
            xb_add(&bar[XB_XGEN(b.x)], 1u);
            asm volatile("s_waitcnt vmcnt(0)" ::: "memory");
        } else {
            XB_SPIN(xb_ld(&bar[XB_XGEN(b.x)]) == gen, bar);
            __builtin_amdgcn_fence(__ATOMIC_ACQUIRE, "agent");
            asm volatile("s_waitcnt vmcnt(0)" ::: "memory");
        }
    }
    __syncthreads();
}
#define GSYNC() do { for (int r_ = 0; r_ < REP_SYNC; ++r_) { XcdBarrier xb_; xb_.bar = (unsigned*)(p.ws + WS_BAR); xb_.x = xb_xcc_id(); xb_.st = (volatile LAS unsigned*)(lds + LDS_XB); xcd_barrier(xb_); } } while (0)
__global__ void __launch_bounds__(512, 2) fwd_megakernel(Params p) {
  extern __shared__ __attribute__((aligned(16))) unsigned char smem[];
  LAS unsigned char* lds = (LAS unsigned char*)smem;
  cg::grid_group grid = cg::this_grid();
  if (threadIdx.x < 4) ((LAS unsigned*)(lds + LDS_XB))[threadIdx.x] = 0u;
  __syncthreads();
  (void)xcd_barrier_post((unsigned*)(p.ws + WS_BAR), (volatile LAS unsigned*)(lds + LDS_XB));
  grid.sync();
  const int G = gridDim.x, bid = blockIdx.x;
#define WSP(T_, off) ((T_*)(p.ws + (off)))
  for (int pl = 0; pl < 12; ++pl) {
    int pass = pl >> 2, layer = pl & 3;
    asm volatile("" : "+s"(pass), "+s"(layer));
    const int S = pass == 0 ? 4096 : 8192;
    {
      if (pl == 0) phase_convert(p, 0, lds, 0, (int)blockIdx.x, (int)gridDim.x);
      unsigned char* wcur = p.ws + ((pl & 1) ? WS_WB : 0);
      if (layer == 0) {
        if ((PH_MASK & 2) && pass > 0) phase_final_norm(WSP(bf16_t, WS_XB), p.out + (size_t)(pass - 1) * T * 1024, WSP(float, WS_SSQ), p.in[21]);
        GSYNC();
        if (PH_MASK & 2) phase_load_rows(pass == 0 ? p.in[0] : p.in[1] + (size_t)(pass - 1) * T * 1024, WSP(bf16_t, WS_XB), WSP(float, WS_SSQ));
      }
      GSYNC();
      for (int r_ = 0; r_ < REP_G1; ++r_) if (PH_MASK & 4) { pg8::Gemm g{WSP(bf16_t, WS_XB), (bf16_t*)(wcur + WS_W1), T, PLD, 1024, 1024, 1 << 20, 0}; pg8::StaticOrder so; so.init(T, PLD, G, bid); EpiProj E{WSP(bf16_t, WS_PROJ), WSP(float, WS_GS), WSP(float, WS_SSQ), S - 1}; pg8::gemm_phase(lds, g, so, E); }
      GSYNC();
      for (int r_ = 0; r_ < REP_MISC; ++r_) if (PH_MASK & 8) phase_conv(WSP(bf16_t, WS_PROJ), WSP(bf16_t, WS_XC), p.in[6] + layer * 4 * 1536, p.in[7] + layer * 1536, S);
      GSYNC();
      for (int r_ = 0; r_ < REP_MIX; ++r_) if (PH_MASK & 16) phase_mixer(p, lds, layer, S, pl < 11 ? ((pl + 1) & 3) : -1, (pl + 1) & 1);
      GSYNC();
      for (int ph_ = 0; ph_ < 2; ++ph_) {
        if (((ph_ ^ (bid >> 3)) & 1) != 0) { for (int r_ = 0; r_ < REP_MISC; ++r_) if (PH_MASK & 32) phase_post(p, layer); }
        else { for (int r2_ = 0; r2_ < REP_G2; ++r2_) if (PH_MASK & 64) { pg8::Gemm g{WSP(bf16_t, WS_XB), (bf16_t*)(wcur + WS_WG), T, 3072, 1024, 1024, 1 << 20, 0}; pg8::StaticOrder so; so.init(T, 3072, G, bid); EpiGate E{WSP(bf16_t, WS_GATE), p.in[5] + layer * 3072, WSP(float, WS_SSQ)}; pg8::gemm_phase(lds, g, so, E); } }
      }
      GSYNC();
      if (PH_MASK & 128) { pg8::Gemm g{WSP(bf16_t, WS_PROJ) + ACT_COL, (bf16_t*)(wcur + WS_W2), T, 3072, 1024, PLD, 4, 1024}; pg8::BranchOrder so; so.init(T, G, bid); EpiBranch E{WSP(bf16_t, WS_GATE), WSP(bf16_t, WS_GATED)}; pg8::gemm_phase(lds, g, so, E); }
      GSYNC();
      if (PH_MASK & 256) { pg8::Gemm g{WSP(bf16_t, WS_GATED), (bf16_t*)(wcur + WS_W3), T, 1024, 1024, 1024, 1 << 20, 0}; pg8::StaticOrder so; so.init(T, 1024, G, bid); EpiRes E{WSP(bf16_t, WS_XB), WSP(float, WS_SSQ)}; pg8::gemm_phase(lds, g, so, E); }
      GSYNC();
      for (int r4_ = 0; r4_ < REP_G4; ++r4_) if (PH_MASK & 512) { pg8::Gemm g{WSP(bf16_t, WS_XB), (bf16_t*)(wcur + WS_W4), T, 5632, 1024, 1024, 1 << 20, 0}; pg8::StaticOrder so; so.init(T, 5632, G, bid); EpiFfn E{WSP(bf16_t, WS_HID), WSP(float, WS_SSQ)}; pg8::gemm_phase(lds, g, so, E); }
      GSYNC();
      if (PH_MASK & 1024) { pg8::Gemm g{WSP(bf16_t, WS_HID), (bf16_t*)(wcur + WS_W5), T, 1024, FF, FF, 1 << 20, 0}; pg8::StaticOrder so; so.init(T, 1024, G, bid); EpiRes E{WSP(bf16_t, WS_XB), WSP(float, WS_SSQ)}; pg8::gemm_phase(lds, g, so, E); }
      GSYNC();
    }
  }
  phase_final_norm(WSP(bf16_t, WS_XB), p.out + (size_t)2 * T * 1024, WSP(float, WS_SSQ), p.in[21]);
}

extern "C" void kernel_launch(void* const* d_in, const int* in_sizes, int n_in, void* d_out, int out_size, void* d_ws, size_t ws_size, hipStream_t stream) {
  static int grid_blocks = 0;
  if (!grid_blocks) {
    int dev = 0, cus = 0, per_cu = 0;
    (void)hipGetDevice(&dev);
    (void)hipDeviceGetAttribute(&cus, hipDeviceAttributeMultiprocessorCount, dev);
    if (hipFuncSetAttribute((const void*)fwd_megakernel, hipFuncAttributeMaxDynamicSharedMemorySize, LDS_BYTES) != hipSuccess) fprintf(stderr, "hipFuncSetAttribute failed\n");
    if (hipOccupancyMaxActiveBlocksPerMultiprocessor(&per_cu, (const void*)fwd_megakernel, 512, LDS_BYTES) != hipSuccess || per_cu < 1) { fprintf(stderr, "occupancy query: %d\n", per_cu); per_cu = 1; }
    (void)hipGetLastError();
    grid_blocks = cus * per_cu;
    if (ws_size < WS_TOTAL || n_in != 22) { fprintf(stderr, "kernel_launch: workspace %zu < %zu or n_in %d\n", ws_size, (size_t)WS_TOTAL, n_in); }
  }
  Params p{};
  for (int i = 0; i < 22; ++i) p.in[i] = (const float*)d_in[i];
  p.out = (float*)d_out; p.ws = (unsigned char*)d_ws;
  (void)hipMemsetAsync((unsigned char*)d_ws + WS_BAR, 0, XCD_BAR_WORDS * 4, stream);
  void* args[] = {&p};
  hipError_t e = hipLaunchCooperativeKernel((const void*)fwd_megakernel, dim3(grid_blocks), dim3(512), args, LDS_BYTES, stream);
  if (e != hipSuccess) fprintf(stderr, "cooperative launch failed: %s (grid %d)\n", hipGetErrorString(e), grid_blocks);
}
```

```cpp
#include <hip/hip_runtime.h>
#include <hip/hip_cooperative_groups.h>
#include <cstdio>
namespace cg = cooperative_groups;
#define LAS __attribute__((address_space(3)))
typedef unsigned short bf16_t;
typedef short bf16x8 __attribute__((ext_vector_type(8)));
typedef float f32x4 __attribute__((ext_vector_type(4)));
typedef float f32x16 __attribute__((ext_vector_type(16)));
typedef unsigned u32x4 __attribute__((ext_vector_type(4)));
typedef unsigned u32x2 __attribute__((ext_vector_type(2)));

constexpr int D = 1024, T = 16384, FF = 2816, NPROJ = 8752, PLD = 8960;
constexpr int C_Z = 0, C_XBC = 1024, C_MLQ = 2560, C_RTQ = 3072, C_RTK = 3584, C_MLK = 4096, C_MLV = 4608, C_MLO = 5632, C_RTV = 6656, C_RTG = 7680, C_DT = 8704, C_MLG = 8736;
constexpr float EPS = 1e-6f;

constexpr size_t WS_W1 = 0;
constexpr size_t WS_WG = WS_W1 + (size_t)PLD * 1024 * 2;
constexpr size_t WS_W2 = WS_WG + (size_t)3072 * 1024 * 2;
constexpr size_t WS_W3 = WS_W2 + (size_t)3072 * 1024 * 2;
constexpr size_t WS_W4 = WS_W3 + (size_t)1024 * 3072 * 2;
constexpr size_t WS_W5 = WS_W4 + (size_t)5632 * 1024 * 2;
constexpr size_t WS_XB = WS_W5 + (size_t)1024 * FF * 2;
constexpr size_t WS_SSQ = WS_XB + (size_t)T * 1024 * 2;
constexpr size_t WS_GS = WS_SSQ + (size_t)T * 16 * 4;
constexpr size_t WS_PROJ = WS_GS + (size_t)T * 48 * 4;
constexpr size_t WS_XC = WS_PROJ + (size_t)T * PLD * 2;
constexpr size_t WS_YF = WS_XC + (size_t)T * 1536 * 2;
constexpr size_t WS_YB = WS_YF + (size_t)T * 3072 * 2;
constexpr size_t WS_ACT = WS_YB + (size_t)T * 3072 * 2;
constexpr size_t WS_END = WS_ACT + (size_t)T * 3072 * 2;
constexpr size_t WS_HID = WS_PROJ;
constexpr size_t WS_GATE = WS_ACT;
constexpr int ACT_COL = 1024;
constexpr size_t WS_GATED = WS_YF;
constexpr size_t WS_BAR = WS_END;
constexpr size_t WS_WB = WS_END + 16384;
constexpr size_t WS_DEN = WS_WB + WS_XB;
constexpr size_t WS_TOTAL = WS_DEN + (size_t)2 * 4 * T * 2 * 4;

struct Params {
  const float* in[22];
  float* out;
  unsigned char* ws;
};

__device__ __forceinline__ int opaque_tid() { int t = threadIdx.x; asm volatile("" : "+v"(t)); return t; }
typedef __bf16 bf16x2_t __attribute__((ext_vector_type(2)));
typedef float f32x2_t __attribute__((ext_vector_type(2)));
__device__ __forceinline__ unsigned cvt_pk_bf16(float lo, float hi) { const f32x2_t v = {lo, hi}; const bf16x2_t b = __builtin_convertvector(v, bf16x2_t); return __builtin_bit_cast(unsigned, b); }
__device__ __forceinline__ bf16_t f2bf(float f) { return (bf16_t)(cvt_pk_bf16(f, 0.f) & 0xffffu); }
__device__ __forceinline__ float bf2f(bf16_t b) { return __uint_as_float(((unsigned)b) << 16); }
__device__ __forceinline__ float bflo(unsigned w) { return __uint_as_float(w << 16); }
__device__ __forceinline__ float bfhi(unsigned w) { return __uint_as_float(w & 0xffff0000u); }
__device__ __forceinline__ float sigmoidf_(float x) { return __builtin_amdgcn_rcpf(1.f + __expf(-x)); }
__device__ __forceinline__ float siluf_(float x) { return x * __builtin_amdgcn_rcpf(1.f + __expf(-x)); }
__device__ __forceinline__ float softplusf_(float x) {
  const float e = __expf(fminf(x, 20.f));
  const float sp = e < 2e-3f ? e * (1.f - 0.5f * e + 0.33333334f * e * e) : __logf(1.f + e);
  return x > 20.f ? x : sp;
}

namespace pg8 {
constexpr int BM = 256, BK = 64, HALF = 128, HTB = HALF * BK * 2, STAGE_BYTES = 8 * HTB, NXCD = 8, WGM = 8;
__host__ __device__ __forceinline__ int lds_byte(int r, int c) { const int st = (r >> 4) * 2 + (c >> 5), rr = r & 15, cc = c & 31, ob = rr * 64 + cc * 2; return st * 1024 + (ob ^ (((ob >> 9) & 1) << 5)); }
__host__ __device__ __forceinline__ void stage_rc(int b, int& R, int& C) { const int st = b / 1024, sb = b % 1024, swz = sb ^ (((sb >> 9) & 1) << 5); R = (st >> 1) * 16 + swz / 64; C = (st & 1) * 32 + (swz % 64) / 2; }
__host__ __device__ __forceinline__ int perm32(int rho) { const int n = rho >> 4, i = rho & 15; return 8 * (i >> 2) + 4 * n + (i & 3); }
struct Unit { int pm, pn; };
struct Gemm { const bf16_t* A; const bf16_t* Bt; int M, N, K, lda; int asel_div; int asel_stride; };
struct StaticOrder {
    int nM, nN, nwg, G, c;
    __device__ void init(int M, int N, int G_, int c_) { nM = M / BM; nN = N / BM; nwg = nM * nN; G = G_; c = c_; }
    __device__ bool next(int i, Unit& u) const {
        const long L = (long)i * G + c; if (L >= nwg) return false;
        int wgid = (int)L; { const int q = nwg / NXCD, r = nwg % NXCD, xcd = wgid % NXCD, off = wgid / NXCD; wgid = (xcd < r ? xcd * (q + 1) : r * (q + 1) + (xcd - r) * q) + off; }
        const int nig = WGM * nN, gid = wgid / nig, fm = gid * WGM, gsz = (nM - fm) < WGM ? (nM - fm) : WGM;
        u.pm = fm + ((wgid % nig) % gsz); u.pn = (wgid % nig) / gsz; return true;
    }
};

struct BranchOrder {
    StaticOrder so;
    __device__ void init(int M, int G_, int c_) { so.init(M, 1024, G_, c_); }
    __device__ bool next(int i, Unit& u) const { Unit t; const int q = i / 3; if (!so.next(q, t)) return false; u.pm = t.pm; u.pn = (i - 3 * q) * 4 + t.pn; return true; }
};
template <class Epi, class Sched>
__device__ __forceinline__ void gemm_phase(LAS unsigned char* lds, const Gemm g, const Sched& S, const Epi& E) {
    const int tid = opaque_tid(), wid = __builtin_amdgcn_readfirstlane(tid >> 6), lane = tid & 63, wr = wid >> 2, wc = wid & 3, fr = lane & 15, fq = lane >> 4;
    const int K = g.K, nt = K / BK;
    unsigned voffA[2], voffB[2];
#pragma unroll
    for (int i = 0; i < 2; ++i) { int R, C; stage_rc(tid * 16 + i * 8192, R, C); const int Rb = Epi::PERM ? ((R & ~31) + perm32(R & 31)) : R;
        voffA[i] = (unsigned)(R * g.lda + C) * 2u; voffB[i] = (unsigned)(Rb * K + C) * 2u; }
    const size_t kstep = (size_t)(BK * 2);
    const size_t hstepA = (size_t)HALF * g.lda * 2, tstepA = 2 * hstepA;
    const size_t hstepB = (size_t)HALF * K * 2, tstepB = 2 * hstepB;
    const unsigned ldsw = (unsigned)wid * 1024u;
    const int aoff = lds_byte(wr * 64 + fr, fq * 8), boff = lds_byte(wc * 32 + fr, fq * 8);
#define PG8_SA(b, h) (((b) * 2 + (h)) * HTB)
#define PG8_SB(b, h) ((4 + (b) * 2 + (h)) * HTB)
#define PG8_STAGE(bufoff, gbase, voff) do { _Pragma("unroll") for (int _i = 0; _i < 2; ++_i) \
        __builtin_amdgcn_global_load_lds((const unsigned*)((const char*)(gbase) + (voff)[_i]), (LAS unsigned*)(lds + (bufoff) + ldsw + _i * 8192), 16, 0, 0); } while (0)
#define PG8_LDA(dst, b, h) do { _Pragma("unroll") for (int m = 0; m < 4; ++m) _Pragma("unroll") for (int k = 0; k < 2; ++k) dst[m][k] = *(const LAS bf16x8*)(lds + PG8_SA(b, h) + aoff + m * 2048 + k * 1024); } while (0)
#define PG8_LDB(dst, b, h) do { _Pragma("unroll") for (int n = 0; n < 2; ++n) _Pragma("unroll") for (int k = 0; k < 2; ++k) dst[n][k] = *(const LAS bf16x8*)(lds + PG8_SB(b, h) + boff + n * 2048 + k * 1024); } while (0)
#define PG8_MMA(ai, bj, At, Bt) do { __builtin_amdgcn_s_setprio(1); _Pragma("unroll") for (int m = 0; m < 4; ++m) _Pragma("unroll") for (int n = 0; n < 2; ++n) _Pragma("unroll") for (int k = 0; k < 2; ++k) \
        acc[ai][bj][m][n] = __builtin_amdgcn_mfma_f32_16x16x32_bf16(Bt[n][k], At[m][k], acc[ai][bj][m][n], 0, 0, 0); __builtin_amdgcn_s_setprio(0); } while (0)
#define PG8_WAIT_V(n) asm volatile("s_waitcnt vmcnt(" #n ")" ::: "memory")
#define PG8_WAIT_L(n) asm volatile("s_waitcnt lgkmcnt(" #n ")" ::: "memory")
#define PG8_BAR __builtin_amdgcn_s_barrier()
#define PG8_SCHED __builtin_amdgcn_sched_barrier(0)
    Unit cur, nxt; int ui = 0;
    if (!S.next(0, cur)) return;
    f32x4 acc[2][2][4][2];
#pragma unroll
    for (int a = 0; a < 2; ++a)
#pragma unroll
        for (int b = 0; b < 2; ++b)
#pragma unroll
            for (int m = 0; m < 4; ++m)
#pragma unroll
                for (int n = 0; n < 2; ++n) acc[a][b][m][n] = (f32x4){0.f, 0.f, 0.f, 0.f};
    bf16x8 At[4][2], B0[2][2], B1[2][2];
    const char* cA = (const char*)g.A + (size_t)(cur.pn / g.asel_div) * g.asel_stride * 2 + (size_t)cur.pm * tstepA; const char* cB = (const char*)g.Bt + (size_t)cur.pn * tstepB;
    PG8_STAGE(PG8_SB(0, 0), cB, voffB); PG8_STAGE(PG8_SA(0, 0), cA, voffA); PG8_STAGE(PG8_SB(0, 1), cB + hstepB, voffB); PG8_STAGE(PG8_SA(0, 1), cA + hstepA, voffA);
    if (wr == 1) PG8_BAR;
    PG8_WAIT_V(4); PG8_BAR;
    PG8_STAGE(PG8_SB(1, 0), cB + kstep, voffB); PG8_STAGE(PG8_SA(1, 0), cA + kstep, voffA); PG8_STAGE(PG8_SB(1, 1), cB + hstepB + kstep, voffB);
    PG8_WAIT_V(6); PG8_BAR;
    for (;;) {
        const bool has_next = S.next(ui + 1, nxt);
        const char* nA = has_next ? (const char*)g.A + (size_t)(nxt.pn / g.asel_div) * g.asel_stride * 2 + (size_t)nxt.pm * tstepA : cA; const char* nB = has_next ? (const char*)g.Bt + (size_t)nxt.pn * tstepB : cB;
        for (int t = 0; t < nt; t += 2) {
            const bool last = (t == nt - 2);
            const char* a1 = cA + (size_t)(t + 1) * kstep;
            const char* a2 = last ? nA : cA + (size_t)(t + 2) * kstep; const char* b2 = last ? nB : cB + (size_t)(t + 2) * kstep;
            const char* a3 = a2 + kstep; const char* b3 = b2 + kstep;
            PG8_LDB(B0, 0, 0); PG8_SCHED; PG8_LDA(At, 0, 0); PG8_STAGE(PG8_SA(1, 1), a1 + hstepA, voffA);
            PG8_WAIT_L(8); PG8_BAR; PG8_WAIT_L(0); PG8_MMA(0, 0, At, B0); PG8_BAR; PG8_SCHED;
            PG8_LDB(B1, 0, 1); PG8_STAGE(PG8_SB(0, 0), b2, voffB);
            PG8_BAR; PG8_WAIT_L(0); PG8_MMA(0, 1, At, B1); PG8_BAR;
            PG8_LDA(At, 0, 1); PG8_STAGE(PG8_SA(0, 0), a2, voffA);
            PG8_BAR; PG8_WAIT_L(0); PG8_MMA(1, 0, At, B0); PG8_BAR; PG8_SCHED;
            PG8_STAGE(PG8_SB(0, 1), b2 + hstepB, voffB);
            PG8_WAIT_V(6); PG8_BAR; PG8_MMA(1, 1, At, B1); PG8_BAR;
            PG8_LDB(B0, 1, 0); PG8_SCHED; PG8_LDA(At, 1, 0); PG8_STAGE(PG8_SA(0, 1), a2 + hstepA, voffA);
            PG8_WAIT_L(8); PG8_BAR; PG8_WAIT_L(0); PG8_MMA(0, 0, At, B0); PG8_BAR; PG8_SCHED;
            PG8_LDB(B1, 1, 1); PG8_STAGE(PG8_SB(1, 0), b3, voffB);
            PG8_BAR; PG8_WAIT_L(0); PG8_MMA(0, 1, At, B1); PG8_BAR;
            PG8_LDA(At, 1, 1); PG8_STAGE(PG8_SA(1, 0), a3, voffA);
            PG8_BAR; PG8_WAIT_L(0); PG8_MMA(1, 0, At, B0); PG8_BAR; PG8_SCHED;
            PG8_STAGE(PG8_SB(1, 1), b3 + hstepB, voffB);
            PG8_WAIT_V(6); PG8_BAR; PG8_MMA(1, 1, At, B1); PG8_BAR;
        }
        E(acc, cur, wr, wc, fr, fq);
        if (!has_next) break;
#pragma unroll
        for (int a = 0; a < 2; ++a)
#pragma unroll
            for (int b = 0; b < 2; ++b)
#pragma unroll
                for (int m = 0; m < 4; ++m)
#pragma unroll
                    for (int n = 0; n < 2; ++n) acc[a][b][m][n] = (f32x4){0.f, 0.f, 0.f, 0.f};
        cur = nxt; cA = nA; cB = nB; ++ui;
    }
    PG8_WAIT_V(0);
    if (wr == 0) PG8_BAR;
    PG8_BAR;
#undef PG8_SA
#undef PG8_SB
#undef PG8_STAGE
#undef PG8_LDA
#undef PG8_LDB
#undef PG8_MMA
#undef PG8_WAIT_V
#undef PG8_WAIT_L
#undef PG8_BAR
#undef PG8_SCHED
}
}
using pg8::Unit;

__device__ __forceinline__ float row_rstd(const float* ssq, int row) {
  const f32x4 a = *(const f32x4*)(ssq + (size_t)row * 4) + *(const f32x4*)(ssq + (size_t)(T + row) * 4) + *(const f32x4*)(ssq + (size_t)(2 * T + row) * 4) + *(const f32x4*)(ssq + (size_t)(3 * T + row) * 4);
  return rsqrtf((a[0] + a[1] + a[2] + a[3]) * (1.0f / 1024.0f) + EPS);
}

struct EpiProj {
  static constexpr bool PERM = true;
  bf16_t* proj; float* gs; const float* ssq; int smask;
  __device__ __forceinline__ void operator()(const f32x4 (&acc)[2][2][4][2], const Unit& u, int wr, int wc, int fr, int fq) const {
    const int row0 = u.pm * 256 + wr * 64 + fr, col0 = u.pn * 256 + wc * 32 + 8 * fq;
    const bool rot = (u.pn >= 12) && (u.pn < 16);
    float inv[8];
    if (rot) {
#pragma unroll
      for (int e = 0; e < 8; ++e) inv[e] = __builtin_amdgcn_exp2f(-(float)((wc * 32 + 8 * fq + e) & 63) * (13.287712379549449f / 64.0f)) * 0.15915494309189535f;
    }
    const float ksc = (u.pn >= 14) ? 0.08838834764831845f : 1.0f;
#pragma unroll
    for (int ai = 0; ai < 2; ++ai) {
      float rs[4];
#pragma unroll
      for (int m = 0; m < 4; ++m) rs[m] = row_rstd(ssq, row0 + ai * 128 + m * 16);
#pragma unroll
      for (int m = 0; m < 4; ++m) {
        const int row = row0 + ai * 128 + m * 16;
        if (rot) {
          const float pos = (float)(row & smask), sc = rs[m] * ksc;
          float o1[8], o2[8];
#pragma unroll
          for (int e = 0; e < 8; ++e) {
            float r = pos * inv[e]; r = r - floorf(r);
            const float sn = __builtin_amdgcn_sinf(r), cs = __builtin_amdgcn_cosf(r);
            const float t1 = acc[ai][0][m][e >> 2][e & 3] * sc, t2 = acc[ai][1][m][e >> 2][e & 3] * sc;
            o1[e] = t1 * cs - t2 * sn; o2[e] = t1 * sn + t2 * cs;
          }
          u32x4 w1, w2;
          w1.x = cvt_pk_bf16(o1[0], o1[1]); w1.y = cvt_pk_bf16(o1[2], o1[3]); w1.z = cvt_pk_bf16(o1[4], o1[5]); w1.w = cvt_pk_bf16(o1[6], o1[7]);
          w2.x = cvt_pk_bf16(o2[0], o2[1]); w2.y = cvt_pk_bf16(o2[2], o2[3]); w2.z = cvt_pk_bf16(o2[4], o2[5]); w2.w = cvt_pk_bf16(o2[6], o2[7]);
          *(u32x4*)(proj + (size_t)row * PLD + col0) = w1; *(u32x4*)(proj + (size_t)row * PLD + col0 + 128) = w2;
        } else {
#pragma unroll
          for (int bj = 0; bj < 2; ++bj) {
            const int c = col0 + bj * 128;
            f32x4 v0 = acc[ai][bj][m][0] * rs[m], v1 = acc[ai][bj][m][1] * rs[m];
            if (c < NPROJ) { u32x4 w; w.x = cvt_pk_bf16(v0[0], v0[1]); w.y = cvt_pk_bf16(v0[2], v0[3]); w.z = cvt_pk_bf16(v1[0], v1[1]); w.w = cvt_pk_bf16(v1[2], v1[3]);
              *(u32x4*)(proj + (size_t)row * PLD + c) = w; }
            if (c >= C_DT && c < C_DT + 32) { float* q = gs + (size_t)row * 32 + (c - C_DT); *(f32x4*)q = v0; *(f32x4*)(q + 4) = v1; }
            if (c >= C_MLG && c < C_MLG + 16) { float* q = gs + (size_t)T * 32 + (size_t)row * 16 + (c - C_MLG); *(f32x4*)q = v0; *(f32x4*)(q + 4) = v1; }
          }
        }
      }
    }
  }
};
struct EpiGate {
  static constexpr bool PERM = true;
  bf16_t* gate; const float* bias; const float* ssq;
  __device__ __forceinline__ void operator()(const f32x4 (&acc)[2][2][4][2], const Unit& u, int wr, int wc, int fr, int fq) const {
    const int row0 = u.pm * 256 + wr * 64 + fr, col0 = u.pn * 256 + wc * 32 + 8 * fq;
    float rs[2][4]; f32x4 bv[2][2];
#pragma unroll
    for (int bj = 0; bj < 2; ++bj) { bv[bj][0] = *(const f32x4*)(bias + col0 + bj * 128); bv[bj][1] = *(const f32x4*)(bias + col0 + bj * 128 + 4); }
#pragma unroll
    for (int ai = 0; ai < 2; ++ai)
#pragma unroll
      for (int m = 0; m < 4; ++m) rs[ai][m] = row_rstd(ssq, row0 + ai * 128 + m * 16);
#pragma unroll
    for (int ai = 0; ai < 2; ++ai)
#pragma unroll
      for (int m = 0; m < 4; ++m) {
        const int row = row0 + ai * 128 + m * 16;
#pragma unroll
        for (int bj = 0; bj < 2; ++bj) {
          const int c = col0 + bj * 128;
          f32x4 v0 = acc[ai][bj][m][0] * rs[ai][m] + bv[bj][0], v1 = acc[ai][bj][m][1] * rs[ai][m] + bv[bj][1];
#pragma unroll
          for (int j = 0; j < 4; ++j) { v0[j] = sigmoidf_(v0[j]); v1[j] = sigmoidf_(v1[j]); }
          u32x4 w; w.x = cvt_pk_bf16(v0[0], v0[1]); w.y = cvt_pk_bf16(v0[2], v0[3]); w.z = cvt_pk_bf16(v1[0], v1[1]); w.w = cvt_pk_bf16(v1[2], v1[3]);
          *(u32x4*)(gate + (size_t)row * 3072 + c) = w;
        }
      }
  }
};
struct EpiBranch {
  static constexpr bool PERM = true;
  const bf16_t* gate; bf16_t* merged;
  __device__ __forceinline__ void operator()(const f32x4 (&acc)[2][2][4][2], const Unit& u, int wr, int wc, int fr, int fq) const {
    const int br = u.pn >> 2;
    const int row0 = u.pm * 256 + wr * 64 + fr, col0 = u.pn * 256 + wc * 32 + 8 * fq, mcol0 = (u.pn & 3) * 256 + wc * 32 + 8 * fq;
#pragma unroll
    for (int ai = 0; ai < 2; ++ai) {
      u32x4 gw[4][2], mw[4][2];
#pragma unroll
      for (int m = 0; m < 4; ++m)
#pragma unroll
        for (int bj = 0; bj < 2; ++bj) {
          gw[m][bj] = *(const u32x4*)(gate + (size_t)(row0 + ai * 128 + m * 16) * 3072 + col0 + bj * 128);
          mw[m][bj] = br ? *(const u32x4*)(merged + (size_t)(row0 + ai * 128 + m * 16) * 1024 + mcol0 + bj * 128) : (u32x4){0u, 0u, 0u, 0u};
        }
#pragma unroll
      for (int m = 0; m < 4; ++m) {
        const int row = row0 + ai * 128 + m * 16;
#pragma unroll
        for (int bj = 0; bj < 2; ++bj) {
          const u32x4 g = gw[m][bj], o = mw[m][bj];
          const f32x4 a0 = acc[ai][bj][m][0], a1 = acc[ai][bj][m][1];
          u32x4 w;
          w.x = cvt_pk_bf16(a0[0] * bflo(g.x) + bflo(o.x), a0[1] * bfhi(g.x) + bfhi(o.x)); w.y = cvt_pk_bf16(a0[2] * bflo(g.y) + bflo(o.y), a0[3] * bfhi(g.y) + bfhi(o.y));
          w.z = cvt_pk_bf16(a1[0] * bflo(g.z) + bflo(o.z), a1[1] * bfhi(g.z) + bfhi(o.z)); w.w = cvt_pk_bf16(a1[2] * bflo(g.w) + bflo(o.w), a1[3] * bfhi(g.w) + bfhi(o.w));
          *(u32x4*)(merged + (size_t)row * 1024 + mcol0 + bj * 128) = w;
        }
      }
    }
  }
};
struct EpiRes {
  static constexpr bool PERM = false;
  bf16_t* xb; float* ssq;
  __device__ __forceinline__ void operator()(const f32x4 (&acc)[2][2][4][2], const Unit& u, int wr, int wc, int fr, int fq) const {
    const int row0 = u.pm * 256 + wr * 64 + fr, col0 = u.pn * 256 + wc * 32 + 4 * fq;
    u32x2 xw[2][4][2][2];
#pragma unroll
    for (int ai = 0; ai < 2; ++ai)
#pragma unroll
      for (int m = 0; m < 4; ++m)
#pragma unroll
        for (int bj = 0; bj < 2; ++bj)
#pragma unroll
          for (int n = 0; n < 2; ++n) xw[ai][m][bj][n] = *(const u32x2*)(xb + (size_t)(row0 + ai * 128 + m * 16) * 1024 + col0 + bj * 128 + n * 16);
#pragma unroll
    for (int ai = 0; ai < 2; ++ai)
#pragma unroll
      for (int m = 0; m < 4; ++m) {
        const int row = row0 + ai * 128 + m * 16; float sq = 0.f;
#pragma unroll
        for (int bj = 0; bj < 2; ++bj)
#pragma unroll
          for (int n = 0; n < 2; ++n) {
            const size_t off = (size_t)row * 1024 + col0 + bj * 128 + n * 16;
            const u32x2 o = xw[ai][m][bj][n];
            f32x4 v = acc[ai][bj][m][n];
            v[0] += bflo(o.x); v[1] += bfhi(o.x); v[2] += bflo(o.y); v[3] += bfhi(o.y);
            u32x2 w; w.x = cvt_pk_bf16(v[0], v[1]); w.y = cvt_pk_bf16(v[2], v[3]);
            *(u32x2*)(xb + off) = w;
            sq += (v[0] * v[0] + v[1] * v[1]) + (v[2] * v[2] + v[3] * v[3]);
          }
        sq += __shfl_xor(sq, 16); sq += __shfl_xor(sq, 32);
        if (fq == 0) ssq[((size_t)u.pn * T + row) * 4 + wc] = sq;
      }
  }
};
struct EpiFfn {
  static constexpr bool PERM = true;
  bf16_t* hid; const float* ssq;
  __device__ __forceinline__ void operator()(const f32x4 (&acc)[2][2][4][2], const Unit& u, int wr, int wc, int fr, int fq) const {
    const int row0 = u.pm * 256 + wr * 64 + fr, hc = u.pn * 128 + wc * 32 + 8 * fq;
    float rs[2][4];
#pragma unroll
    for (int ai = 0; ai < 2; ++ai)
#pragma unroll
      for (int m = 0; m < 4; ++m) rs[ai][m] = row_rstd(ssq, row0 + ai * 128 + m * 16);
#pragma unroll
    for (int ai = 0; ai < 2; ++ai)
#pragma unroll
      for (int m = 0; m < 4; ++m) {
        const int row = row0 + ai * 128 + m * 16; const float r = rs[ai][m];
        f32x4 o0, o1;
#pragma unroll
        for (int j = 0; j < 4; ++j) {
          o0[j] = siluf_(acc[ai][0][m][0][j] * r) * (acc[ai][1][m][0][j] * r);
          o1[j] = siluf_(acc[ai][0][m][1][j] * r) * (acc[ai][1][m][1][j] * r);
        }
        u32x4 w; w.x = cvt_pk_bf16(o0[0], o0[1]); w.y = cvt_pk_bf16(o0[2], o0[3]); w.z = cvt_pk_bf16(o1[0], o1[1]); w.w = cvt_pk_bf16(o1[2], o1[3]);
        *(u32x4*)(hid + (size_t)row * FF + hc) = w;
      }
  }
};

__device__ __forceinline__ int map_w1(int r) {
  if (r < 2560) return r;
  if (r < 3072) return r + 32;
  if (r < 4096) { const int isk = r >= 3584, q = r - (isk ? 3584 : 3072), t = q >> 8, w = q & 255, head = 2 * t + ((w >> 6) & 1), half = w >> 7, i = w & 63;
                  return (isk ? 6192 : 5680) + head * 128 + half * 64 + i; }
  if (r < 4608) return r - 4096 + 3104;
  if (r < 5632) return r - 4608 + 3616;
  if (r < 6656) return r - 5632 + 4640;
  if (r < 7680) return r - 6656 + 6704;
  if (r < 8704) return r - 7680 + 7728;
  if (r < 8736) return r - 8704 + 2560;
  if (r < 8752) return r - 8736 + 5664;
  return -1;
}
__device__ __forceinline__ void cvt_tile(LAS float* tl, const float* src, int sld, int k0, int n0, int nvalid, const float* scale,
                                         bf16_t* dst, int dld, int r0, int c0, int ncopy, bool w1map) {
  const int tid = opaque_tid();
#pragma unroll
  for (int it = 0; it < 2; ++it) {
    const int k = (tid >> 4) + it * 32, n4 = (tid & 15) * 4;
    f32x4 v = (f32x4){0.f, 0.f, 0.f, 0.f};
    const int sc_ = w1map ? map_w1(n0 + n4) : (n0 + n4 < nvalid ? n0 + n4 : -1);
    if (sc_ >= 0) v = *(const f32x4*)(src + (size_t)(k0 + k) * sld + sc_);
    const float s = scale ? scale[k0 + k] : 1.f;
    tl[k * 65 + n4 + 0] = v[0] * s; tl[k * 65 + n4 + 1] = v[1] * s; tl[k * 65 + n4 + 2] = v[2] * s; tl[k * 65 + n4 + 3] = v[3] * s;
  }
  __syncthreads();
  const int n = tid >> 3, k8 = (tid & 7) * 8;
  u32x4 w;
  w.x = cvt_pk_bf16(tl[(k8 + 0) * 65 + n], tl[(k8 + 1) * 65 + n]); w.y = cvt_pk_bf16(tl[(k8 + 2) * 65 + n], tl[(k8 + 3) * 65 + n]);
  w.z = cvt_pk_bf16(tl[(k8 + 4) * 65 + n], tl[(k8 + 5) * 65 + n]); w.w = cvt_pk_bf16(tl[(k8 + 6) * 65 + n], tl[(k8 + 7) * 65 + n]);
  for (int cp = 0; cp < ncopy; ++cp) *(u32x4*)(dst + (size_t)(r0 + n) * dld + c0 + cp * 1024 + k8) = w;
  __syncthreads();
}

__device__ void phase_convert(const Params& p, int layer, LAS unsigned char* lds, int parity, int first, int stride) {
  LAS float* tl = (LAS float*)lds;
  const float* gmix = p.in[2] + layer * 1024;
  const float* w_in = p.in[3] + (size_t)layer * 1024 * NPROJ;
  const float* w_gate = p.in[4] + (size_t)layer * 1024 * 3072;
  const float* w_branch = p.in[15] + (size_t)layer * 3 * 1024 * 1024;
  const float* w_out = p.in[16] + (size_t)layer * 1024 * 1024;
  const float* gffn = p.in[17] + layer * 1024;
  const float* w_fg = p.in[18] + (size_t)layer * 1024 * FF;
  const float* w_fu = p.in[19] + (size_t)layer * 1024 * FF;
  const float* w_fd = p.in[20] + (size_t)layer * FF * 1024;
  unsigned char* wb = p.ws + (parity ? WS_WB : 0);
  bf16_t* W1 = (bf16_t*)(wb + WS_W1); bf16_t* WG = (bf16_t*)(wb + WS_WG); bf16_t* W2 = (bf16_t*)(wb + WS_W2);
  bf16_t* W3 = (bf16_t*)(wb + WS_W3); bf16_t* W4 = (bf16_t*)(wb + WS_W4); bf16_t* W5 = (bf16_t*)(wb + WS_W5);
  for (int t = first; t < 6144; t += stride) {
    int i = t;
    const float* src; const float* scale = nullptr; bf16_t* dst; int sld, k0, n0, nvalid, dld, r0, ncopy = 1;
    if (i < 2240) { const int nt = i >> 4; k0 = (i & 15) * 64; n0 = nt * 64; src = w_in; sld = NPROJ; nvalid = NPROJ; scale = gmix; dst = W1; dld = 1024; r0 = n0; }
    else if ((i -= 2240) < 768) { const int nt = i >> 4; k0 = (i & 15) * 64; n0 = nt * 64; src = w_gate; sld = 3072; nvalid = 3072; scale = gmix; dst = WG; dld = 1024; r0 = n0; }
    else if ((i -= 768) < 768) { const int br = i >> 8, j = i & 255, nt = j >> 4; k0 = (j & 15) * 64; n0 = nt * 64; src = w_branch + (size_t)br * 1024 * 1024; sld = 1024; nvalid = 1024; dst = W2; dld = 1024; r0 = br * 1024 + n0; }
    else if ((i -= 768) < 256) { const int nt = i >> 4; k0 = (i & 15) * 64; n0 = nt * 64; src = w_out; sld = 1024; nvalid = 1024; dst = W3; dld = 1024; r0 = n0; }
    else if ((i -= 256) < 1408) { const int nt = i >> 4, pp = nt >> 2, half = (nt >> 1) & 1, sub = nt & 1; k0 = (i & 15) * 64; n0 = pp * 128 + sub * 64; src = half ? w_fu : w_fg; sld = FF; nvalid = FF; scale = gffn; dst = W4; dld = 1024; r0 = pp * 256 + half * 128 + sub * 64; }
    else { i -= 1408; const int nt = i / 44; k0 = (i % 44) * 64; n0 = nt * 64; src = w_fd; sld = 1024; nvalid = 1024; dst = W5; dld = FF; r0 = n0; }
    cvt_tile(tl, src, sld, k0, n0, nvalid, scale, dst, dld, r0, k0, ncopy, t < 2240);
  }
}

__device__ void phase_load_rows(const float* xin, bf16_t* xb, float* ssq) {
  const int tid_ = opaque_tid(); const int lane = tid_ & 63, wid = tid_ >> 6;
  for (int row = blockIdx.x * 8 + wid; row < T; row += gridDim.x * 8) {
    float sq = 0.f;
#pragma unroll
    for (int i = 0; i < 4; ++i) {
      const size_t off = (size_t)row * 1024 + i * 256 + lane * 4;
      const f32x4 v = *(const f32x4*)(xin + off);
      u32x2 w; w.x = cvt_pk_bf16(v[0], v[1]); w.y = cvt_pk_bf16(v[2], v[3]); *(u32x2*)(xb + off) = w;
      sq += (v[0] * v[0] + v[1] * v[1]) + (v[2] * v[2] + v[3] * v[3]);
    }
#pragma unroll
    for (int o = 1; o < 64; o <<= 1) sq += __shfl_xor(sq, o);
    if (lane < 16) ssq[((size_t)(lane >> 2) * T + row) * 4 + (lane & 3)] = lane == 0 ? sq : 0.f;
  }
}
__device__ void phase_final_norm(const bf16_t* xb, float* out, const float* ssq, const float* g) {
  const int tid_ = opaque_tid(); const int lane = tid_ & 63, wid = tid_ >> 6;
  for (int row = blockIdx.x * 8 + wid; row < T; row += gridDim.x * 8) {
    const float rs = row_rstd(ssq, row);
#pragma unroll
    for (int i = 0; i < 4; ++i) {
      const size_t off = (size_t)row * 1024 + i * 256 + lane * 4;
      const u32x2 w = *(const u32x2*)(xb + off); const f32x4 gg = *(const f32x4*)(g + i * 256 + lane * 4);
      const f32x4 v = (f32x4){bflo(w.x), bfhi(w.x), bflo(w.y), bfhi(w.y)};
      *(f32x4*)(out + off) = v * rs * gg;
    }
  }
}

__device__ void phase_conv(const bf16_t* __restrict__ proj, bf16_t* __restrict__ xc, const float* cw, const float* cb, int S) {
  const int tid_ = opaque_tid();
  const int nitems = 192 * (T / 32);
  for (int id = blockIdx.x * 512 + tid_; id < nitems; id += gridDim.x * 512) {
    const int cg = id % 192, c8 = cg * 8, t0 = (id / 192) * 32, pos0 = t0 % S;
    float wt[4][8], bs[8];
#pragma unroll
    for (int e = 0; e < 8; ++e) bs[e] = cb[c8 + e];
#pragma unroll
    for (int tau = 0; tau < 4; ++tau)
#pragma unroll
      for (int e = 0; e < 8; ++e) wt[tau][e] = cw[tau * 1536 + c8 + e];
    const bf16_t* src = proj + C_XBC + c8;
    const u32x4 zero = (u32x4){0u, 0u, 0u, 0u};
    u32x4 w0 = (pos0 >= 2) ? *(const u32x4*)(src + (size_t)(t0 - 2) * PLD) : zero;
    u32x4 w1 = (pos0 >= 1) ? *(const u32x4*)(src + (size_t)(t0 - 1) * PLD) : zero;
    u32x4 w2 = *(const u32x4*)(src + (size_t)t0 * PLD);
#pragma unroll 1
    for (int b = 0; b < 4; ++b) {
      u32x4 nx[8];
#pragma unroll
      for (int k = 0; k < 8; ++k) { const int tt = t0 + b * 8 + k + 1; nx[k] = (pos0 + b * 8 + k + 1 < S) ? *(const u32x4*)(src + (size_t)tt * PLD) : zero; }
#pragma unroll
      for (int k = 0; k < 8; ++k) {
        const u32x4 w3 = nx[k];
        float a[8];
        const unsigned r0[4] = {w0.x, w0.y, w0.z, w0.w}, r1[4] = {w1.x, w1.y, w1.z, w1.w}, r2[4] = {w2.x, w2.y, w2.z, w2.w}, r3[4] = {w3.x, w3.y, w3.z, w3.w};
#pragma unroll
        for (int q = 0; q < 4; ++q) {
          a[2 * q] = bs[2 * q] + bflo(r0[q]) * wt[0][2 * q] + bflo(r1[q]) * wt[1][2 * q] + bflo(r2[q]) * wt[2][2 * q] + bflo(r3[q]) * wt[3][2 * q];
          a[2 * q + 1] = bs[2 * q + 1] + bfhi(r0[q]) * wt[0][2 * q + 1] + bfhi(r1[q]) * wt[1][2 * q + 1] + bfhi(r2[q]) * wt[2][2 * q + 1] + bfhi(r3[q]) * wt[3][2 * q + 1];
        }
#pragma unroll
        for (int e = 0; e < 8; ++e) a[e] = siluf_(a[e]);
        u32x4 o; o.x = cvt_pk_bf16(a[0], a[1]); o.y = cvt_pk_bf16(a[2], a[3]); o.z = cvt_pk_bf16(a[4], a[5]); o.w = cvt_pk_bf16(a[6], a[7]);
        *(u32x4*)(xc + (size_t)(t0 + b * 8 + k) * 1536 + c8) = o;
        w0 = w1; w1 = w2; w2 = w3;
      }
    }
  }
}

__device__ void phase_rope(bf16_t* proj, int S) {
  const int tid_ = opaque_tid();
  const size_t total = (size_t)T * 32;
  for (size_t id = (size_t)blockIdx.x * 512 + tid_; id < total; id += (size_t)gridDim.x * 512) {
    const int t = (int)(id >> 5), hd = (int)(id >> 3) & 3, ch = (int)id & 7;
    bf16_t* src = proj + (size_t)t * PLD + hd * 128 + ch * 8;
    const u32x4 q1 = *(const u32x4*)(src + C_RTQ), q2 = *(const u32x4*)(src + C_RTQ + 64), k1 = *(const u32x4*)(src + C_RTK), k2 = *(const u32x4*)(src + C_RTK + 64);
    const float pos = (float)(t % S);
    float cs[8], sn[8];
#pragma unroll
    for (int e = 0; e < 8; ++e) {
      const float inv = __builtin_amdgcn_exp2f(-(float)(ch * 8 + e) * (13.287712379549449f / 64.0f));
      float r = pos * inv * 0.15915494309189535f; r = r - floorf(r);
      sn[e] = __builtin_amdgcn_sinf(r); cs[e] = __builtin_amdgcn_cosf(r);
    }
    const float ksc = 0.08838834764831845f;
    const unsigned qa[4] = {q1.x, q1.y, q1.z, q1.w}, qb[4] = {q2.x, q2.y, q2.z, q2.w}, ka[4] = {k1.x, k1.y, k1.z, k1.w}, kb[4] = {k2.x, k2.y, k2.z, k2.w};
    unsigned oq1[4], oq2[4], ok1[4], ok2[4];
#pragma unroll
    for (int w = 0; w < 4; ++w) {
      const float a0 = bflo(qa[w]), a1 = bfhi(qa[w]), b0 = bflo(qb[w]), b1 = bfhi(qb[w]);
      oq1[w] = cvt_pk_bf16(a0 * cs[2 * w] - b0 * sn[2 * w], a1 * cs[2 * w + 1] - b1 * sn[2 * w + 1]);
      oq2[w] = cvt_pk_bf16(a0 * sn[2 * w] + b0 * cs[2 * w], a1 * sn[2 * w + 1] + b1 * cs[2 * w + 1]);
      const float e0 = bflo(ka[w]) * ksc, e1 = bfhi(ka[w]) * ksc, g0 = bflo(kb[w]) * ksc, g1 = bfhi(kb[w]) * ksc;
      ok1[w] = cvt_pk_bf16(e0 * cs[2 * w] - g0 * sn[2 * w], e1 * cs[2 * w + 1] - g1 * sn[2 * w + 1]);
      ok2[w] = cvt_pk_bf16(e0 * sn[2 * w] + g0 * cs[2 * w], e1 * sn[2 * w + 1] + g1 * cs[2 * w + 1]);
    }
    *(u32x4*)(src + C_RTQ) = (u32x4){oq1[0], oq1[1], oq1[2], oq1[3]};
    *(u32x4*)(src + C_RTQ + 64) = (u32x4){oq2[0], oq2[1], oq2[2], oq2[3]};
    *(u32x4*)(src + C_RTK) = (u32x4){ok1[0], ok1[1], ok1[2], ok1[3]};
    *(u32x4*)(src + C_RTK + 64) = (u32x4){ok2[0], ok2[1], ok2[2], ok2[3]};
  }
}

constexpr int MXP = 272;
constexpr int MX_Q = 0, MX_K = 34816, MX_KT = 69632, MX_VT = 104448, MX_HT = 121856, MX_V = 139264, MX_N = 155648, MX_VEC = 155904, MX_END = MX_VEC + 7 * 512 + 64;
constexpr int LDS_XB = MX_END > pg8::STAGE_BYTES ? MX_END : pg8::STAGE_BYTES;
constexpr int LDS_BYTES = LDS_XB + 16;

__device__ __forceinline__ int swz(int row, int col) { return row * MXP + col * 2; }
__device__ __forceinline__ bf16x8 ldfrag(LAS const unsigned char* base, int row0, int ks, int lane) {
  const int row = row0 + (lane & 31);
  return *(LAS const bf16x8*)(base + row * MXP + (lane >> 5) * 16 + ks * 32);
}
__device__ __forceinline__ u32x4 scale_pk(u32x4 v, float s) {
  u32x4 w; w.x = cvt_pk_bf16(bflo(v.x) * s, bfhi(v.x) * s); w.y = cvt_pk_bf16(bflo(v.y) * s, bfhi(v.y) * s);
  w.z = cvt_pk_bf16(bflo(v.z) * s, bfhi(v.z) * s); w.w = cvt_pk_bf16(bflo(v.w) * s, bfhi(v.w) * s); return w;
}

template <int BR, bool DEN>
__device__ void mixer_item(const Params& p, LAS unsigned char* lds, int layer, int S, int seq, int dir, int ht) {
  const int tid = opaque_tid(), wid = __builtin_amdgcn_readfirstlane(tid >> 6), lane = tid & 63, rb = wid >> 1, cb = wid & 1;
  const bf16_t* proj = (const bf16_t*)(p.ws + WS_PROJ);
  const bf16_t* xc = (const bf16_t*)(p.ws + WS_XC);
  const float* gs = (const float*)(p.ws + WS_GS);
  bf16_t* yout = (bf16_t*)(p.ws + (dir ? WS_YB : WS_YF));
  LAS float* vC = (LAS float*)(lds + MX_VEC); LAS float* vMu = vC + 128; LAS float* vW = vC + 256; LAS float* vR = vC + 384; LAS float* vCl = vC + 512; LAS float* vVs = vC + 640; LAS float* sc = vC + 896;
  constexpr bool STAB = (BR == 1);
  int hd, vt, ocol;
  if (BR == 0) { hd = ht; vt = 0; ocol = ht * 64; } else if (DEN) { hd = ht; vt = 0; ocol = 0; } else { hd = ht >> 2; vt = ht & 3; ocol = (BR == 1 ? 1024 : 2048) + hd * 256 + vt * 64; }
  float cst_a = 0.f, cst_b = 0.f, cst_c = 0.f;
  if (BR == 0) { cst_a = -expf(p.in[8][layer * 32 + dir * 16 + hd]); cst_b = p.in[9][layer * 32 + dir * 16 + hd]; }
  if (BR == 1) { cst_b = p.in[12][layer * 16 + (2 * dir) * 4 + hd]; cst_c = p.in[12][layer * 16 + (2 * dir + 1) * 4 + hd]; }
  if (BR == 2) { cst_a = logf(1.0f - exp2f(-5.0f - (4.0f / 3.0f) * (float)hd)); }
  const int nc = S / 128;
  const int seqbase = seq * S;
  f32x16 Hacc;
#pragma unroll
  for (int j = 0; j < 16; ++j) Hacc[j] = 0.f;
  float m_st = 0.f;
  { unsigned z0 = 0u; asm volatile("" : "+v"(z0)); const u32x4 zv = (u32x4){z0, z0, z0, z0};
    for (int i = tid; i < 64 * MXP / 16; i += 512) *(LAS u32x4*)(lds + MX_HT + i * 16) = zv;
    if (tid < 16) *(LAS u32x4*)(lds + MX_N + tid * 16) = zv; }

  u32x4 ra[8], rv[2]; float rg[4] = {0.f, 0.f, 0.f, 0.f};
#define MX_ISSUE_LOADS(ci_) do { \
    const int tk_ = seqbase + (ci_) * 128; \
    { \
      _Pragma("unroll") for (int it = 0; it < 4; ++it) { const int id = it * 512 + tid, row = id >> 4, ch = id & 15; \
        if (BR == 1) { const bf16_t* src = proj + (size_t)(tk_ + row) * PLD + hd * 128 + ch * 8; ra[it] = *(const u32x4*)(src + C_MLQ); ra[4 + it] = *(const u32x4*)(src + C_MLK); } \
        else if (BR == 2) { const bf16_t* src = proj + (size_t)(tk_ + row) * PLD + (hd >> 1) * 256 + (ch >> 3) * 128 + (hd & 1) * 64 + (ch & 7) * 8; ra[it] = *(const u32x4*)(src + C_RTQ); ra[4 + it] = *(const u32x4*)(src + C_RTK); } \
        else { const bf16_t* src = xc + (size_t)(tk_ + row) * 1536 + (hd >> 3) * 128 + ch * 8; ra[it] = *(const u32x4*)(src + 1280); ra[4 + it] = *(const u32x4*)(src + 1024); } } \
    } \
    _Pragma("unroll") for (int it = 0; it < 2; ++it) { const int id = it * 512 + tid, row = id >> 3, ch = id & 7; \
      if (DEN) rv[it] = (u32x4){0x3F803F80u, 0x3F803F80u, 0x3F803F80u, 0x3F803F80u}; \
      else if (BR == 0) rv[it] = *(const u32x4*)(xc + (size_t)(tk_ + row) * 1536 + hd * 64 + ch * 8); \
      else rv[it] = *(const u32x4*)(proj + (size_t)(tk_ + row) * PLD + (BR == 1 ? C_MLV : C_RTV) + hd * 256 + vt * 64 + ch * 8); } \
    if (wid == 0 && BR != 2) { const int q0_ = dir ? 127 - 2 * lane : 2 * lane, q1_ = dir ? 126 - 2 * lane : 2 * lane + 1; \
      if (BR == 0) { rg[0] = gs[(size_t)(tk_ + q0_) * 32 + dir * 16 + hd]; rg[1] = gs[(size_t)(tk_ + q1_) * 32 + dir * 16 + hd]; } \
      else { const float* gg = gs + (size_t)T * 32; rg[0] = gg[(size_t)(tk_ + q0_) * 16 + (2 * dir + 1) * 4 + hd]; rg[1] = gg[(size_t)(tk_ + q1_) * 16 + (2 * dir + 1) * 4 + hd]; \
        rg[2] = gg[(size_t)(tk_ + q0_) * 16 + (2 * dir) * 4 + hd]; rg[3] = gg[(size_t)(tk_ + q1_) * 16 + (2 * dir) * 4 + hd]; } } \
  } while (0)
  MX_ISSUE_LOADS(dir ? nc - 1 : 0);

  for (int c = 0; c < nc; ++c) {
    const int ci = dir ? nc - 1 - c : c;
    const int tok0 = seqbase + ci * 128;
    if (wid == 0) {
      const int j0 = 2 * lane, j1 = j0 + 1;
      const int p0 = dir ? 127 - j0 : j0, p1 = dir ? 127 - j1 : j1;
      float l0, l1, b0 = 0.f, b1 = 0.f, d0 = 1.f, d1 = 1.f;
      if (BR == 0) {
        d0 = softplusf_(rg[0] + cst_b); d1 = softplusf_(rg[1] + cst_b);
        l0 = d0 * cst_a; l1 = d1 * cst_a;
      } else if (BR == 1) {
        l0 = -softplusf_(-(rg[0] + cst_c)); l1 = -softplusf_(-(rg[1] + cst_c));
        b0 = rg[2] + cst_b; b1 = rg[3] + cst_b;
      } else { l0 = cst_a; l1 = cst_a; }
      float run = l0 + l1;
#pragma unroll
      for (int o = 1; o < 64; o <<= 1) { const float t = __shfl_up(run, o); if (lane >= o) run += t; }
      const float A1 = run, A0 = run - l1;
      const float A_end = __shfl(A1, 63);
      const float c0 = b0 - A0, c1 = b1 - A1;
      float mu0, mu1, mu_end;
      if (STAB) {
        float rm = fmaxf(c0, c1);
#pragma unroll
        for (int o = 1; o < 64; o <<= 1) { const float t = __shfl_up(rm, o); if (lane >= o) rm = fmaxf(rm, t); }
        const float ex = __shfl_up(rm, 1);
        const float pm0 = lane > 0 ? fmaxf(ex, c0) : c0, pm1 = rm;
        mu0 = fmaxf(m_st, pm0); mu1 = fmaxf(m_st, pm1); mu_end = fmaxf(m_st, __shfl(pm1, 63));
      } else { mu0 = -A0; mu1 = -A1; mu_end = -A_end; }
      vC[p0] = c0; vC[p1] = c1; vMu[p0] = mu0; vMu[p1] = mu1;
      vW[p0] = __expf(c0 - mu_end); vW[p1] = __expf(c1 - mu_end);
      vR[p0] = __expf(m_st - mu0); vR[p1] = __expf(m_st - mu1);
      vCl[p0] = STAB ? __expf(-A0 - mu0) : 0.f; vCl[p1] = STAB ? __expf(-A1 - mu1) : 0.f;
      vVs[p0] = d0; vVs[p1] = d1;
      if (lane == 0) sc[0] = __expf(m_st - mu_end);
      m_st = STAB ? A_end + mu_end : 0.f;
    }
    {
#pragma unroll
      for (int it = 0; it < 4; ++it) {
        const int id = it * 512 + tid, row = id >> 4, ch = id & 15;
        *(LAS u32x4*)(lds + MX_Q + swz(row, ch * 8)) = BR == 1 ? scale_pk(ra[it], 0.08838834764831845f) : ra[it];
        *(LAS u32x4*)(lds + MX_K + swz(row, ch * 8)) = ra[4 + it];
      }
    }
#pragma unroll
    for (int it = 0; it < 2; ++it) {
      const int id = it * 512 + tid, row = id >> 3, ch = id & 7;
      *(LAS u32x4*)(lds + MX_V + row * 128 + ch * 16) = rv[it];
    }
    __syncthreads();
    {
      const int dk = tid & 127, sg = tid >> 7, dv = tid & 63, sv = tid >> 6;
      unsigned short kr[32], vr[16];
      f32x4 w4[8], vs4[4];
#pragma unroll
      for (int i = 0; i < 32; ++i) kr[i] = *(LAS const bf16_t*)(lds + MX_K + swz(sg * 32 + i, dk));
#pragma unroll
      for (int i = 0; i < 16; ++i) vr[i] = *(LAS const bf16_t*)(lds + MX_V + (sv * 16 + i) * 128 + dv * 2);
#pragma unroll
      for (int i = 0; i < 8; ++i) w4[i] = *(LAS const f32x4*)(vW + sg * 32 + i * 4);
      if (BR == 0) {
#pragma unroll
        for (int i = 0; i < 4; ++i) vs4[i] = *(LAS const f32x4*)(vVs + sv * 16 + i * 4);
      }
      __builtin_amdgcn_sched_barrier(0);
#pragma unroll
      for (int s8 = 0; s8 < 4; ++s8) {
        float f[8];
#pragma unroll
        for (int e = 0; e < 8; ++e) f[e] = bf2f(kr[s8 * 8 + e]) * w4[s8 * 2 + (e >> 2)][e & 3];
        u32x4 w; w.x = cvt_pk_bf16(f[0], f[1]); w.y = cvt_pk_bf16(f[2], f[3]); w.z = cvt_pk_bf16(f[4], f[5]); w.w = cvt_pk_bf16(f[6], f[7]);
        *(LAS u32x4*)(lds + MX_KT + swz(dk, sg * 32 + s8 * 8)) = w;
      }
#pragma unroll
      for (int s8 = 0; s8 < 2; ++s8) {
        float f[8];
#pragma unroll
        for (int e = 0; e < 8; ++e) { f[e] = bf2f(vr[s8 * 8 + e]); if (BR == 0) f[e] *= vs4[s8 * 2 + (e >> 2)][e & 3]; }
        u32x4 w; w.x = cvt_pk_bf16(f[0], f[1]); w.y = cvt_pk_bf16(f[2], f[3]); w.z = cvt_pk_bf16(f[4], f[5]); w.w = cvt_pk_bf16(f[6], f[7]);
        *(LAS u32x4*)(lds + MX_VT + swz(dv, sv * 16 + s8 * 8)) = w;
      }
    }
    __syncthreads();
    f32x16 S0, S1, QH;
#pragma unroll
    for (int j = 0; j < 16; ++j) { S0[j] = 0.f; S1[j] = 0.f; QH[j] = 0.f; }
    {
      const float dec = sc[0];
#pragma unroll
      for (int j = 0; j < 16; ++j) { Hacc[j] *= dec; }
      bf16x8 fa[2], fb0[2], fb1[2], fhb[2], fka[2], fvb[2];
      fa[0] = ldfrag(lds + MX_Q, 32 * rb, 0, lane); fb0[0] = ldfrag(lds + MX_K, 64 * cb, 0, lane); fb1[0] = ldfrag(lds + MX_K, 64 * cb + 32, 0, lane);
      fhb[0] = ldfrag(lds + MX_HT, 32 * cb, 0, lane); fka[0] = ldfrag(lds + MX_KT, 32 * rb, 0, lane); fvb[0] = ldfrag(lds + MX_VT, 32 * cb, 0, lane);
#pragma unroll
      for (int ks = 0; ks < 8; ++ks) {
        const int cur = ks & 1, nxt = cur ^ 1;
        if (ks < 7) {
          fa[nxt] = ldfrag(lds + MX_Q, 32 * rb, ks + 1, lane); fb0[nxt] = ldfrag(lds + MX_K, 64 * cb, ks + 1, lane); fb1[nxt] = ldfrag(lds + MX_K, 64 * cb + 32, ks + 1, lane);
          fhb[nxt] = ldfrag(lds + MX_HT, 32 * cb, ks + 1, lane); fka[nxt] = ldfrag(lds + MX_KT, 32 * rb, ks + 1, lane); fvb[nxt] = ldfrag(lds + MX_VT, 32 * cb, ks + 1, lane);
        }
        __builtin_amdgcn_sched_barrier(0);
        S0 = __builtin_amdgcn_mfma_f32_32x32x16_bf16(fa[cur], fb0[cur], S0, 0, 0, 0);
        S1 = __builtin_amdgcn_mfma_f32_32x32x16_bf16(fa[cur], fb1[cur], S1, 0, 0, 0);
        QH = __builtin_amdgcn_mfma_f32_32x32x16_bf16(fa[cur], fhb[cur], QH, 0, 0, 0);
        Hacc = __builtin_amdgcn_mfma_f32_32x32x16_bf16(fka[cur], fvb[cur], Hacc, 0, 0, 0);
        __builtin_amdgcn_sched_barrier(0);
      }
    }
    __syncthreads();
    { const int cn = c + 1 < nc ? c + 1 : c; MX_ISSUE_LOADS(dir ? nc - 1 - cn : cn); }
    {
      const int sA = 64 * cb + (lane & 31), sB = sA + 32;
      const float cA = vC[sA], cB = vC[sB];
      float mu16[16];
#pragma unroll
      for (int j = 0; j < 16; ++j) mu16[j] = vMu[32 * rb + 8 * (j >> 2) + 4 * (lane >> 5) + (j & 3)];
      __builtin_amdgcn_sched_barrier(0);
#pragma unroll
      for (int j = 0; j < 16; ++j) {
        const int t = 32 * rb + 8 * (j >> 2) + 4 * (lane >> 5) + (j & 3);
        const float mu = mu16[j];
        bool okA, okB;
        if (dir == 0) { okA = sA <= t; okB = sB <= t; } else if (BR == 2) { okA = sA > t; okB = sB > t; } else { okA = sA >= t; okB = sB >= t; }
        const float pa = okA ? S0[j] * __expf(cA - mu) : 0.f, pb = okB ? S1[j] * __expf(cB - mu) : 0.f;
        *(LAS bf16_t*)(lds + MX_Q + swz(t, sA)) = f2bf(pa);
        *(LAS bf16_t*)(lds + MX_Q + swz(t, sB)) = f2bf(pb);
      }
#pragma unroll
      for (int g4 = 0; g4 < 4; ++g4) {
        const int dk0 = 32 * rb + 8 * g4 + 4 * (lane >> 5), dvr = 32 * cb + (lane & 31);
        u32x2 w; w.x = cvt_pk_bf16(Hacc[4 * g4 + 0], Hacc[4 * g4 + 1]); w.y = cvt_pk_bf16(Hacc[4 * g4 + 2], Hacc[4 * g4 + 3]);
        *(LAS u32x2*)(lds + MX_HT + swz(dvr, dk0)) = w;
      }
    }
    __syncthreads();
    {
      float rsc[16];
#pragma unroll
      for (int j = 0; j < 16; ++j) { const int t = 32 * rb + 8 * (j >> 2) + 4 * (lane >> 5) + (j & 3); rsc[j] = vR[t]; QH[j] *= rsc[j]; }
      bf16x8 pa[2], pv[2];
      pa[0] = ldfrag(lds + MX_Q, 32 * rb, 0, lane); pv[0] = ldfrag(lds + MX_VT, 32 * cb, 0, lane);
#pragma unroll
      for (int ks = 0; ks < 8; ++ks) {
        const int cur = ks & 1, nxt = cur ^ 1;
        if (ks < 7) { pa[nxt] = ldfrag(lds + MX_Q, 32 * rb, ks + 1, lane); pv[nxt] = ldfrag(lds + MX_VT, 32 * cb, ks + 1, lane); }
        __builtin_amdgcn_sched_barrier(0);
        QH = __builtin_amdgcn_mfma_f32_32x32x16_bf16(pa[cur], pv[cur], QH, 0, 0, 0);
        __builtin_amdgcn_sched_barrier(0);
      }
#pragma unroll
      for (int j = 0; j < 16; ++j) {
        const int t = 32 * rb + 8 * (j >> 2) + 4 * (lane >> 5) + (j & 3);
        const float y = QH[j];
        if (DEN) { if (cb == 0 && (lane & 31) == 0) { float* dp = (float*)(p.ws + WS_DEN) + (((size_t)(dir * 4 + hd) * T) + tok0 + t) * 2; dp[0] = y; dp[1] = vCl[t]; } }
        else yout[(size_t)(tok0 + t) * 3072 + ocol + 32 * cb + (lane & 31)] = f2bf(y);
      }
    }
    __syncthreads();
  }
}

#undef MX_ISSUE_LOADS
__device__ void phase_mixer(const Params& p, LAS unsigned char* lds, int layer, int S, int conv_layer, int conv_parity) {
  const int nseq = T / S, nitems = nseq * 2 * 52;
  for (int it = blockIdx.x; it < nitems; it += gridDim.x) {
    const int ht_ord = it / (nseq * 2), rem = it % (nseq * 2), seq = rem >> 1, dir = rem & 1;
#ifdef ONLY_BR
    mixer_item<ONLY_BR, false>(p, lds, layer, S, seq, dir, ht_ord & 15);
#else
    if (ht_ord < 16) mixer_item<1, false>(p, lds, layer, S, seq, dir, ht_ord);
    else if (ht_ord < 20) mixer_item<1, true>(p, lds, layer, S, seq, dir, ht_ord - 16);
    else if (ht_ord < 36) mixer_item<2, false>(p, lds, layer, S, seq, dir, ht_ord - 20);
    else mixer_item<0, false>(p, lds, layer, S, seq, dir, ht_ord - 36);
#endif
  }
  if (conv_layer >= 0) {
    const int G = gridDim.x, rem = nitems % G, nconv = G - rem;
    if ((int)blockIdx.x >= rem) phase_convert(p, conv_layer, lds, conv_parity, (int)blockIdx.x - rem, nconv);
  }
}

__device__ void phase_post(const Params& p, int layer) {
  const int tid_ = opaque_tid(); const int lane = tid_ & 63, wid = tid_ >> 6;
  const bf16_t* proj = (const bf16_t*)(p.ws + WS_PROJ); const bf16_t* xc = (const bf16_t*)(p.ws + WS_XC);
  const bf16_t* yf = (const bf16_t*)(p.ws + WS_YF); const bf16_t* yb = (const bf16_t*)(p.ws + WS_YB);
  const float* den = (const float*)(p.ws + WS_DEN);
  bf16_t* act = (bf16_t*)(p.ws + WS_PROJ) + ACT_COL;
  const float* dsk = p.in[10] + layer * 16; const float* g_ssd = p.in[11] + layer * 1024; const float* g_ml = p.in[13] + layer * 1024; const float* g_rt = p.in[14] + layer * 1024;
  for (int row = blockIdx.x * 8 + wid; row < T; row += gridDim.x * 8) {
    u32x4 wf[3][2], wb[3][2], wg[3][2], wx[2]; float dn[2][4];
#pragma unroll
    for (int br = 0; br < 3; ++br)
#pragma unroll
      for (int k = 0; k < 2; ++k) {
        const int c = br * 1024 + k * 512 + lane * 8;
        wf[br][k] = *(const u32x4*)(yf + (size_t)row * 3072 + c); wb[br][k] = *(const u32x4*)(yb + (size_t)row * 3072 + c);
        const int gcol = (br == 0 ? C_Z : (br == 1 ? C_MLO : C_RTG)) + k * 512 + lane * 8;
        wg[br][k] = *(const u32x4*)(proj + (size_t)row * PLD + gcol);
      }
#pragma unroll
    for (int k = 0; k < 2; ++k) {
      wx[k] = *(const u32x4*)(xc + (size_t)row * 1536 + k * 512 + lane * 8);
      const int h = k * 2 + (lane >> 5);
      const float* df = den + (((size_t)(0 * 4 + h) * T) + row) * 2; const float* db = den + (((size_t)(1 * 4 + h) * T) + row) * 2;
      dn[k][0] = df[0]; dn[k][1] = df[1]; dn[k][2] = db[0]; dn[k][3] = db[1];
    }
#pragma unroll
    for (int br = 0; br < 3; ++br) {
      float y[2][8], gt[2][8], sq[2];
#pragma unroll
      for (int k = 0; k < 2; ++k) {
        const unsigned aa[4] = {wf[br][k].x, wf[br][k].y, wf[br][k].z, wf[br][k].w}, bb[4] = {wb[br][k].x, wb[br][k].y, wb[br][k].z, wb[br][k].w}, gg[4] = {wg[br][k].x, wg[br][k].y, wg[br][k].z, wg[br][k].w};
        float nf = 1.f, nb = 1.f;
        if (br == 1) { nf = 1.0f / fmaxf(fabsf(dn[k][0]), dn[k][1]); nb = 1.0f / fmaxf(fabsf(dn[k][2]), dn[k][3]); }
#pragma unroll
        for (int w = 0; w < 4; ++w) {
          y[k][2 * w] = bflo(aa[w]) * nf + bflo(bb[w]) * nb; y[k][2 * w + 1] = bfhi(aa[w]) * nf + bfhi(bb[w]) * nb;
          gt[k][2 * w] = bflo(gg[w]); gt[k][2 * w + 1] = bfhi(gg[w]);
        }
        if (br == 0) {
          const float dd = dsk[k * 8 + (lane >> 3)];
          const unsigned xx[4] = {wx[k].x, wx[k].y, wx[k].z, wx[k].w};
#pragma unroll
          for (int w = 0; w < 4; ++w) { y[k][2 * w] += bflo(xx[w]) * dd; y[k][2 * w + 1] += bfhi(xx[w]) * dd; }
#pragma unroll
          for (int e = 0; e < 8; ++e) y[k][e] *= siluf_(gt[k][e]);
        }
        float q = 0.f;
#pragma unroll
        for (int e = 0; e < 8; ++e) q += y[k][e] * y[k][e];
        q += __shfl_xor(q, 1); q += __shfl_xor(q, 2); q += __shfl_xor(q, 4); q += __shfl_xor(q, 8); q += __shfl_xor(q, 16);
        sq[k] = q;
      }
      float rs[2];
      if (br == 0) { float t = sq[0] + sq[1]; t += __shfl_xor(t, 32); rs[0] = rs[1] = rsqrtf(t * (1.0f / 1024.0f) + EPS); }
      else { rs[0] = rsqrtf(sq[0] * (1.0f / 256.0f) + EPS); rs[1] = rsqrtf(sq[1] * (1.0f / 256.0f) + EPS); }
#pragma unroll
      for (int k = 0; k < 2; ++k) {
        const float* gn = (br == 0 ? g_ssd : (br == 1 ? g_ml : g_rt)) + k * 512 + lane * 8;
        const f32x4 g0 = *(const f32x4*)gn, g1 = *(const f32x4*)(gn + 4);
        unsigned o[4];
#pragma unroll
        for (int e = 0; e < 8; e += 2) {
          float v0 = y[k][e] * rs[k] * (e < 4 ? g0[e] : g1[e - 4]), v1 = y[k][e + 1] * rs[k] * (e < 4 ? g0[e + 1] : g1[e - 3]);
          if (br == 1) { v0 *= sigmoidf_(gt[k][e]); v1 *= sigmoidf_(gt[k][e + 1]); }
          if (br == 2) { v0 *= siluf_(gt[k][e]); v1 *= siluf_(gt[k][e + 1]); }
          o[e >> 1] = cvt_pk_bf16(v0, v1);
        }
        *(u32x4*)(act + (size_t)row * PLD + br * 1024 + k * 512 + lane * 8) = (u32x4){o[0], o[1], o[2], o[3]};
      }
    }
  }
}

#ifndef PH_MASK
#define PH_MASK 0xFFFF
#endif
#ifndef REP_SYNC
#define REP_SYNC 1
#endif
#ifndef REP_MIX
#define REP_MIX 1
#endif
#ifndef REP_G1
#define REP_G1 1
#endif
#ifndef REP_MISC
#define REP_MISC 1
#endif
#ifndef REP_G2
#define REP_G2 1
#endif
#ifndef REP_G4
#define REP_G4 1
#endif
#define XB_TMO      128
#define XB_XCNT(j)  (256  + 64 * (j))
#define XB_XSUB(j)  (1280 + 64 * (j))
#define XB_XGEN(j)  (2304 + 64 * (j))
#define XB_TOP      3328
#define XB_TOPGEN   3392
#define XCD_BAR_WORDS 3456
#define XB_SPIN_CAP (1u << 22)

__device__ __forceinline__ unsigned xb_ld(unsigned* p)              { return __hip_atomic_load(p, __ATOMIC_RELAXED, __HIP_MEMORY_SCOPE_AGENT); }
__device__ __forceinline__ unsigned xb_add(unsigned* p, unsigned v) { return __hip_atomic_fetch_add(p, v, __ATOMIC_RELAXED, __HIP_MEMORY_SCOPE_AGENT); }
__device__ __forceinline__ unsigned xb_xcc_id() { return (unsigned)__builtin_amdgcn_s_getreg((3 << 11) | 20) & 0xFu; }
#define XB_SPIN(cond, bar) do { unsigned _sp = 0; while (cond) { __builtin_amdgcn_s_sleep(1); \
    if ((++_sp & 255u) == 0u) { if (xb_ld(&(bar)[XB_TMO])) break; if (_sp > XB_SPIN_CAP) { atomicAdd(&(bar)[XB_TMO], 1u); break; } } } } while (0)
struct XcdBarrier { unsigned* bar; unsigned x; volatile LAS unsigned* st; };
__device__ __forceinline__ XcdBarrier xcd_barrier_post(unsigned* bar, volatile LAS unsigned* st) {
    XcdBarrier b; b.bar = bar; b.x = xb_xcc_id(); b.st = st;
    if (threadIdx.x == 0) (void)xb_add(&bar[XB_XCNT(b.x)], 1u);
    return b;
}
__device__ __forceinline__ void xcd_barrier_complete(unsigned* bar, unsigned x, unsigned& nloc, unsigned& nx) {
    const unsigned G = gridDim.x * gridDim.y * gridDim.z;
    unsigned sum, cnt, mine, sp = 0u;
    for (;;) {
        sum = 0u; cnt = 0u; mine = 0u;
#pragma unroll
        for (unsigned j = 0; j < 16; ++j) { const unsigned c = xb_ld(&bar[XB_XCNT(j)]); sum += c; cnt += (c > 0u) ? 1u : 0u; mine = (j == x) ? c : mine; }
        if (sum == G) break;
        __builtin_amdgcn_s_sleep(1);
        if ((++sp & 255u) == 0u) { if (xb_ld(&bar[XB_TMO])) break; if (sp > XB_SPIN_CAP) { atomicAdd(&bar[XB_TMO], 1u); break; } }
    }
    nloc = mine > 0u ? mine : 1u; nx = cnt > 0u ? cnt : 1u;
}
__device__ __forceinline__ void xcd_barrier(const XcdBarrier& b) {
    asm volatile("s_waitcnt vmcnt(0)" ::: "memory");
    __syncthreads();
    if (threadIdx.x == 0) {
        unsigned* bar = b.bar;
        __builtin_amdgcn_s_waitcnt(0);
        unsigned nloc = b.st[0], nx = b.st[1];
        if (nloc == 0u) { xcd_barrier_complete(bar, b.x, nloc, nx); b.st[0] = nloc; b.st[1] = nx; }
        const unsigned old = xb_add(&bar[XB_XSUB(b.x)], 1u);
        const unsigned gen = old / nloc;
        if (old + 1u == (gen + 1u) * nloc) {
            __builtin_amdgcn_fence(__ATOMIC_RELEASE, "agent");
            asm volatile("s_waitcnt vmcnt(0)" ::: "memory");
            const unsigned og = xb_add(&bar[XB_TOP], 1u);
            const unsigned tg = og / nx;
            if (og + 1u == (tg + 1u) * nx) xb_add(&bar[XB_TOPGEN], 1u);
            else XB_SPIN(xb_ld(&bar[XB_TOPGEN]) == tg, bar);
            __builtin_amdgcn_fence(__ATOMIC_ACQUIRE, "agent");
            xb_add(&bar[XB_XGEN(b.x)], 1u);
            asm volatile("s_waitcnt vmcnt(0)" ::: "memory");
        } else {
            XB_SPIN(xb_ld(&bar[XB_XGEN(b.x)]) == gen, bar);
            __builtin_amdgcn_fence(__ATOMIC_ACQUIRE, "agent");
            asm volatile("s_waitcnt vmcnt(0)" ::: "memory");
        }
    }
    __syncthreads();
}
#define GSYNC() do { for (int r_ = 0; r_ < REP_SYNC; ++r_) { XcdBarrier xb_; xb_.bar = (unsigned*)(p.ws + WS_BAR); xb_.x = xb_xcc_id(); xb_.st = (volatile LAS unsigned*)(lds + LDS_XB); xcd_barrier(xb_); } } while (0)
__global__ void __launch_bounds__(512, 2) fwd_megakernel(Params p) {
  extern __shared__ __attribute__((aligned(16))) unsigned char smem[];
  LAS unsigned char* lds = (LAS unsigned char*)smem;
  cg::grid_group grid = cg::this_grid();
  if (threadIdx.x < 4) ((LAS unsigned*)(lds + LDS_XB))[threadIdx.x] = 0u;
  __syncthreads();
  (void)xcd_barrier_post((unsigned*)(p.ws + WS_BAR), (volatile LAS unsigned*)(lds + LDS_XB));
  grid.sync();
  const int G = gridDim.x, bid = blockIdx.x;
#define WSP(T_, off) ((T_*)(p.ws + (off)))
  for (int pl = 0; pl < 12; ++pl) {
    int pass = pl >> 2, layer = pl & 3;
    asm volatile("" : "+s"(pass), "+s"(layer));
    const int S = pass == 0 ? 4096 : 8192;
    {
      if (pl == 0) phase_convert(p, 0, lds, 0, (int)blockIdx.x, (int)gridDim.x);
      unsigned char* wcur = p.ws + ((pl & 1) ? WS_WB : 0);
      if (layer == 0) {
        if ((PH_MASK & 2) && pass > 0) phase_final_norm(WSP(bf16_t, WS_XB), p.out + (size_t)(pass - 1) * T * 1024, WSP(float, WS_SSQ), p.in[21]);
        GSYNC();
        if (PH_MASK & 2) phase_load_rows(pass == 0 ? p.in[0] : p.in[1] + (size_t)(pass - 1) * T * 1024, WSP(bf16_t, WS_XB), WSP(float, WS_SSQ));
      }
      GSYNC();
      for (int r_ = 0; r_ < REP_G1; ++r_) if (PH_MASK & 4) { pg8::Gemm g{WSP(bf16_t, WS_XB), (bf16_t*)(wcur + WS_W1), T, PLD, 1024, 1024, 1 << 20, 0}; pg8::StaticOrder so; so.init(T, PLD, G, bid); EpiProj E{WSP(bf16_t, WS_PROJ), WSP(float, WS_GS), WSP(float, WS_SSQ), S - 1}; pg8::gemm_phase(lds, g, so, E); }
      GSYNC();
      for (int r_ = 0; r_ < REP_MISC; ++r_) if (PH_MASK & 8) phase_conv(WSP(bf16_t, WS_PROJ), WSP(bf16_t, WS_XC), p.in[6] + layer * 4 * 1536, p.in[7] + layer * 1536, S);
      GSYNC();
      for (int r_ = 0; r_ < REP_MIX; ++r_) if (PH_MASK & 16) phase_mixer(p, lds, layer, S, pl < 11 ? ((pl + 1) & 3) : -1, (pl + 1) & 1);
      GSYNC();
      for (int ph_ = 0; ph_ < 2; ++ph_) {
        if (((ph_ ^ (bid >> 3)) & 1) != 0) { for (int r_ = 0; r_ < REP_MISC; ++r_) if (PH_MASK & 32) phase_post(p, layer); }
        else { for (int r2_ = 0; r2_ < REP_G2; ++r2_) if (PH_MASK & 64) { pg8::Gemm g{WSP(bf16_t, WS_XB), (bf16_t*)(wcur + WS_WG), T, 3072, 1024, 1024, 1 << 20, 0}; pg8::StaticOrder so; so.init(T, 3072, G, bid); EpiGate E{WSP(bf16_t, WS_GATE), p.in[5] + layer * 3072, WSP(float, WS_SSQ)}; pg8::gemm_phase(lds, g, so, E); } }
      }
      GSYNC();
      if (PH_MASK & 128) { pg8::Gemm g{WSP(bf16_t, WS_PROJ) + ACT_COL, (bf16_t*)(wcur + WS_W2), T, 3072, 1024, PLD, 4, 1024}; pg8::BranchOrder so; so.init(T, G, bid); EpiBranch E{WSP(bf16_t, WS_GATE), WSP(bf16_t, WS_GATED)}; pg8::gemm_phase(lds, g, so, E); }
      GSYNC();
      if (PH_MASK & 256) { pg8::Gemm g{WSP(bf16_t, WS_GATED), (bf16_t*)(wcur + WS_W3), T, 1024, 1024, 1024, 1 << 20, 0}; pg8::StaticOrder so; so.init(T, 1024, G, bid); EpiRes E{WSP(bf16_t, WS_XB), WSP(float, WS_SSQ)}; pg8::gemm_phase(lds, g, so, E); }
      GSYNC();
      for (int r4_ = 0; r4_ < REP_G4; ++r4_) if (PH_MASK & 512) { pg8::Gemm g{WSP(bf16_t, WS_XB), (bf16_t*)(wcur + WS_W4), T, 5632, 1024, 1024, 1 << 20, 0}; pg8::StaticOrder so; so.init(T, 5632, G, bid); EpiFfn E{WSP(bf16_t, WS_HID), WSP(float, WS_SSQ)}; pg8::gemm_phase(lds, g, so, E); }
      GSYNC();
      if (PH_MASK & 1024) { pg8::Gemm g{WSP(bf16_t, WS_HID), (bf16_t*)(wcur + WS_W5), T, 1024, FF, FF, 1 << 20, 0}; pg8::StaticOrder so; so.init(T, 1024, G, bid); EpiRes E{WSP(bf16_t, WS_XB), WSP(float, WS_SSQ)}; pg8::gemm_phase(lds, g, so, E); }
      GSYNC();
    }
  }
  phase_final_norm(WSP(bf16_t, WS_XB), p.out + (size_t)2 * T * 1024, WSP(float, WS_SSQ), p.in[21]);
}

extern "C" void kernel_launch(void* const* d_in, const int* in_sizes, int n_in, void* d_out, int out_size, void* d_ws, size_t ws_size, hipStream_t stream) {
  static int grid_blocks = 0;
  if (!grid_blocks) {
    int dev = 0, cus = 0, per_cu = 0;
    (void)hipGetDevice(&dev);
    (void)hipDeviceGetAttribute(&cus, hipDeviceAttributeMultiprocessorCount, dev);
    if (hipFuncSetAttribute((const void*)fwd_megakernel, hipFuncAttributeMaxDynamicSharedMemorySize, LDS_BYTES) != hipSuccess) fprintf(stderr, "hipFuncSetAttribute failed\n");
    if (hipOccupancyMaxActiveBlocksPerMultiprocessor(&per_cu, (const void*)fwd_megakernel, 512, LDS_BYTES) != hipSuccess || per_cu < 1) { fprintf(stderr, "occupancy query: %d\n", per_cu); per_cu = 1; }
    (void)hipGetLastError();
    grid_blocks = cus * per_cu;
    if (ws_size < WS_TOTAL || n_in != 22) { fprintf(stderr, "kernel_launch: workspace %zu < %zu or n_in %d\n", ws_size, (size_t)WS_TOTAL, n_in); }
  }
  Params p{};
  for (int i = 0; i < 22; ++i) p.in[i] = (const float*)d_in[i];
  p.out = (float*)d_out; p.ws = (unsigned char*)d_ws;
  (void)hipMemsetAsync((unsigned char*)d_ws + WS_BAR, 0, XCD_BAR_WORDS * 4, stream);
  void* args[] = {&p};
  hipError_t e = hipLaunchCooperativeKernel((const void*)fwd_megakernel, dim3(grid_blocks), dim3(512), args, LDS_BYTES, stream);
  if (e != hipSuccess) fprintf(stderr, "cooperative launch failed: %s (grid %d)\n", hipGetErrorString(e), grid_blocks);
}
```

```cpp
#include <hip/hip_runtime.h>
#include <hip/hip_cooperative_groups.h>
#include <cstdio>
namespace cg = cooperative_groups;
#define LAS __attribute__((address_space(3)))
typedef unsigned short bf16_t;
typedef short bf16x8 __attribute__((ext_vector_type(8)));
typedef float f32x4 __attribute__((ext_vector_type(4)));
typedef float f32x16 __attribute__((ext_vector_type(16)));
typedef unsigned u32x4 __attribute__((ext_vector_type(4)));
typedef unsigned u32x2 __attribute__((ext_vector_type(2)));

constexpr int D = 1024, T = 16384, FF = 2816, NPROJ = 8752, PLD = 8960;
constexpr int C_Z = 0, C_XBC = 1024, C_MLQ = 2560, C_RTQ = 3072, C_RTK = 3584, C_MLK = 4096, C_MLV = 4608, C_MLO = 5632, C_RTV = 6656, C_RTG = 7680, C_DT = 8704, C_MLG = 8736;
constexpr float EPS = 1e-6f;

constexpr size_t WS_W1 = 0;
constexpr size_t WS_WG = WS_W1 + (size_t)PLD * 1024 * 2;
constexpr size_t WS_W2 = WS_WG + (size_t)3072 * 1024 * 2;
constexpr size_t WS_W3 = WS_W2 + (size_t)3072 * 1024 * 2;
constexpr size_t WS_W4 = WS_W3 + (size_t)1024 * 3072 * 2;
constexpr size_t WS_W5 = WS_W4 + (size_t)5632 * 1024 * 2;
constexpr size_t WS_XB = WS_W5 + (size_t)1024 * FF * 2;
constexpr size_t WS_SSQ = WS_XB + (size_t)T * 1024 * 2;
constexpr size_t WS_GS = WS_SSQ + (size_t)T * 16 * 4;
constexpr size_t WS_PROJ = WS_GS + (size_t)T * 48 * 4;
constexpr size_t WS_XC = WS_PROJ + (size_t)T * PLD * 2;
constexpr size_t WS_YF = WS_XC + (size_t)T * 1536 * 2;
constexpr size_t WS_YB = WS_YF + (size_t)T * 3072 * 2;
constexpr size_t WS_ACT = WS_YB + (size_t)T * 3072 * 2;
constexpr size_t WS_END = WS_ACT + (size_t)T * 3072 * 2;
constexpr size_t WS_HID = WS_PROJ;
constexpr size_t WS_GATE = WS_ACT;
constexpr int ACT_COL = 1024;
constexpr size_t WS_GATED = WS_YF;
constexpr size_t WS_BAR = WS_END;
constexpr size_t WS_WB = WS_END + 16384;
constexpr size_t WS_DEN = WS_WB + WS_XB;
constexpr size_t WS_TOTAL = WS_DEN + (size_t)2 * 4 * T * 2 * 4;

struct Params {
  const float* in[22];
  float* out;
  unsigned char* ws;
};

__device__ __forceinline__ int opaque_tid() { int t = threadIdx.x; asm volatile("" : "+v"(t)); return t; }
typedef __bf16 bf16x2_t __attribute__((ext_vector_type(2)));
typedef float f32x2_t __attribute__((ext_vector_type(2)));
__device__ __forceinline__ unsigned cvt_pk_bf16(float lo, float hi) { const f32x2_t v = {lo, hi}; const bf16x2_t b = __builtin_convertvector(v, bf16x2_t); return __builtin_bit_cast(unsigned, b); }
__device__ __forceinline__ bf16_t f2bf(float f) { return (bf16_t)(cvt_pk_bf16(f, 0.f) & 0xffffu); }
__device__ __forceinline__ float bf2f(bf16_t b) { return __uint_as_float(((unsigned)b) << 16); }
__device__ __forceinline__ float bflo(unsigned w) { return __uint_as_float(w << 16); }
__device__ __forceinline__ float bfhi(unsigned w) { return __uint_as_float(w & 0xffff0000u); }
__device__ __forceinline__ float sigmoidf_(float x) { return __builtin_amdgcn_rcpf(1.f + __expf(-x)); }
__device__ __forceinline__ float siluf_(float x) { return x * __builtin_amdgcn_rcpf(1.f + __expf(-x)); }
__device__ __forceinline__ float softplusf_(float x) {
  const float e = __expf(fminf(x, 20.f));
  const float sp = e < 2e-3f ? e * (1.f - 0.5f * e + 0.33333334f * e * e) : __logf(1.f + e);
  return x > 20.f ? x : sp;
}

namespace pg8 {
constexpr int BM = 256, BK = 64, HALF = 128, HTB = HALF * BK * 2, STAGE_BYTES = 8 * HTB, NXCD = 8, WGM = 8;
__host__ __device__ __forceinline__ int lds_byte(int r, int c) { const int st = (r >> 4) * 2 + (c >> 5), rr = r & 15, cc = c & 31, ob = rr * 64 + cc * 2; return st * 1024 + (ob ^ (((ob >> 9) & 1) << 5)); }
__host__ __device__ __forceinline__ void stage_rc(int b, int& R, int& C) { const int st = b / 1024, sb = b % 1024, swz = sb ^ (((sb >> 9) & 1) << 5); R = (st >> 1) * 16 + swz / 64; C = (st & 1) * 32 + (swz % 64) / 2; }
__host__ __device__ __forceinline__ int perm32(int rho) { const int n = rho >> 4, i = rho & 15; return 8 * (i >> 2) + 4 * n + (i & 3); }
struct Unit { int pm, pn; };
struct Gemm { const bf16_t* A; const bf16_t* Bt; int M, N, K, lda; int asel_div; int asel_stride; };
struct StaticOrder {
    int nM, nN, nwg, G, c;
    __device__ void init(int M, int N, int G_, int c_) { nM = M / BM; nN = N / BM; nwg = nM * nN; G = G_; c = c_; }
    __device__ bool next(int i, Unit& u) const {
        const long L = (long)i * G + c; if (L >= nwg) return false;
        int wgid = (int)L; { const int q = nwg / NXCD, r = nwg % NXCD, xcd = wgid % NXCD, off = wgid / NXCD; wgid = (xcd < r ? xcd * (q + 1) : r * (q + 1) + (xcd - r) * q) + off; }
        const int nig = WGM * nN, gid = wgid / nig, fm = gid * WGM, gsz = (nM - fm) < WGM ? (nM - fm) : WGM;
        u.pm = fm + ((wgid % nig) % gsz); u.pn = (wgid % nig) / gsz; return true;
    }
};

struct BranchOrder {
    StaticOrder so;
    __device__ void init(int M, int G_, int c_) { so.init(M, 1024, G_, c_); }
    __device__ bool next(int i, Unit& u) const { Unit t; const int q = i / 3; if (!so.next(q, t)) return false; u.pm = t.pm; u.pn = (i - 3 * q) * 4 + t.pn; return true; }
};
template <class Epi, class Sched>
__device__ __forceinline__ void gemm_phase(LAS unsigned char* lds, const Gemm g, const Sched& S, const Epi& E) {
    const int tid = opaque_tid(), wid = __builtin_amdgcn_readfirstlane(tid >> 6), lane = tid & 63, wr = wid >> 2, wc = wid & 3, fr = lane & 15, fq = lane >> 4;
    const int K = g.K, nt = K / BK;
    unsigned voffA[2], voffB[2];
#pragma unroll
    for (int i = 0; i < 2; ++i) { int R, C; stage_rc(tid * 16 + i * 8192, R, C); const int Rb = Epi::PERM ? ((R & ~31) + perm32(R & 31)) : R;
        voffA[i] = (unsigned)(R * g.lda + C) * 2u; voffB[i] = (unsigned)(Rb * K + C) * 2u; }
    const size_t kstep = (size_t)(BK * 2);
    const size_t hstepA = (size_t)HALF * g.lda * 2, tstepA = 2 * hstepA;
    const size_t hstepB = (size_t)HALF * K * 2, tstepB = 2 * hstepB;
    const unsigned ldsw = (unsigned)wid * 1024u;
    const int aoff = lds_byte(wr * 64 + fr, fq * 8), boff = lds_byte(wc * 32 + fr, fq * 8);
#define PG8_SA(b, h) (((b) * 2 + (h)) * HTB)
#define PG8_SB(b, h) ((4 + (b) * 2 + (h)) * HTB)
#define PG8_STAGE(bufoff, gbase, voff) do { _Pragma("unroll") for (int _i = 0; _i < 2; ++_i) \
        __builtin_amdgcn_global_load_lds((const unsigned*)((const char*)(gbase) + (voff)[_i]), (LAS unsigned*)(lds + (bufoff) + ldsw + _i * 8192), 16, 0, 0); } while (0)
#define PG8_LDA(dst, b, h) do { _Pragma("unroll") for (int m = 0; m < 4; ++m) _Pragma("unroll") for (int k = 0; k < 2; ++k) dst[m][k] = *(const LAS bf16x8*)(lds + PG8_SA(b, h) + aoff + m * 2048 + k * 1024); } while (0)
#define PG8_LDB(dst, b, h) do { _Pragma("unroll") for (int n = 0; n < 2; ++n) _Pragma("unroll") for (int k = 0; k < 2; ++k) dst[n][k] = *(const LAS bf16x8*)(lds + PG8_SB(b, h) + boff + n * 2048 + k * 1024); } while (0)
#define PG8_MMA(ai, bj, At, Bt) do { __builtin_amdgcn_s_setprio(1); _Pragma("unroll") for (int m = 0; m < 4; ++m) _Pragma("unroll") for (int n = 0; n < 2; ++n) _Pragma("unroll") for (int k = 0; k < 2; ++k) \
        acc[ai][bj][m][n] = __builtin_amdgcn_mfma_f32_16x16x32_bf16(Bt[n][k], At[m][k], acc[ai][bj][m][n], 0, 0, 0); __builtin_amdgcn_s_setprio(0); } while (0)
#define PG8_WAIT_V(n) asm volatile("s_waitcnt vmcnt(" #n ")" ::: "memory")
#define PG8_WAIT_L(n) asm volatile("s_waitcnt lgkmcnt(" #n ")" ::: "memory")
#define PG8_BAR __builtin_amdgcn_s_barrier()
#define PG8_SCHED __builtin_amdgcn_sched_barrier(0)
    Unit cur, nxt; int ui = 0;
    if (!S.next(0, cur)) return;
    f32x4 acc[2][2][4][2];
#pragma unroll
    for (int a = 0; a < 2; ++a)
#pragma unroll
        for (int b = 0; b < 2; ++b)
#pragma unroll
            for (int m = 0; m < 4; ++m)
#pragma unroll
                for (int n = 0; n < 2; ++n) acc[a][b][m][n] = (f32x4){0.f, 0.f, 0.f, 0.f};
    bf16x8 At[4][2], B0[2][2], B1[2][2];
    const char* cA = (const char*)g.A + (size_t)(cur.pn / g.asel_div) * g.asel_stride * 2 + (size_t)cur.pm * tstepA; const char* cB = (const char*)g.Bt + (size_t)cur.pn * tstepB;
    PG8_STAGE(PG8_SB(0, 0), cB, voffB); PG8_STAGE(PG8_SA(0, 0), cA, voffA); PG8_STAGE(PG8_SB(0, 1), cB + hstepB, voffB); PG8_STAGE(PG8_SA(0, 1), cA + hstepA, voffA);
    if (wr == 1) PG8_BAR;
    PG8_WAIT_V(4); PG8_BAR;
    PG8_STAGE(PG8_SB(1, 0), cB + kstep, voffB); PG8_STAGE(PG8_SA(1, 0), cA + kstep, voffA); PG8_STAGE(PG8_SB(1, 1), cB + hstepB + kstep, voffB);
    PG8_WAIT_V(6); PG8_BAR;
    for (;;) {
        const bool has_next = S.next(ui + 1, nxt);
        const char* nA = has_next ? (const char*)g.A + (size_t)(nxt.pn / g.asel_div) * g.asel_stride * 2 + (size_t)nxt.pm * tstepA : cA; const char* nB = has_next ? (const char*)g.Bt + (size_t)nxt.pn * tstepB : cB;
        for (int t = 0; t < nt; t += 2) {
            const bool last = (t == nt - 2);
            const char* a1 = cA + (size_t)(t + 1) * kstep;
            const char* a2 = last ? nA : cA + (size_t)(t + 2) * kstep; const char* b2 = last ? nB : cB + (size_t)(t + 2) * kstep;
            const char* a3 = a2 + kstep; const char* b3 = b2 + kstep;
            PG8_LDB(B0, 0, 0); PG8_SCHED; PG8_LDA(At, 0, 0); PG8_STAGE(PG8_SA(1, 1), a1 + hstepA, voffA);
            PG8_WAIT_L(8); PG8_BAR; PG8_WAIT_L(0); PG8_MMA(0, 0, At, B0); PG8_BAR; PG8_SCHED;
            PG8_LDB(B1, 0, 1); PG8_STAGE(PG8_SB(0, 0), b2, voffB);
            PG8_BAR; PG8_WAIT_L(0); PG8_MMA(0, 1, At, B1); PG8_BAR;
            PG8_LDA(At, 0, 1); PG8_STAGE(PG8_SA(0, 0), a2, voffA);
            PG8_BAR; PG8_WAIT_L(0); PG8_MMA(1, 0, At, B0); PG8_BAR; PG8_SCHED;
            PG8_STAGE(PG8_SB(0, 1), b2 + hstepB, voffB);
            PG8_WAIT_V(6); PG8_BAR; PG8_MMA(1, 1, At, B1); PG8_BAR;
            PG8_LDB(B0, 1, 0); PG8_SCHED; PG8_LDA(At, 1, 0); PG8_STAGE(PG8_SA(0, 1), a2 + hstepA, voffA);
            PG8_WAIT_L(8); PG8_BAR; PG8_WAIT_L(0); PG8_MMA(0, 0, At, B0); PG8_BAR; PG8_SCHED;
            PG8_LDB(B1, 1, 1); PG8_STAGE(PG8_SB(1, 0), b3, voffB);
            PG8_BAR; PG8_WAIT_L(0); PG8_MMA(0, 1, At, B1); PG8_BAR;
            PG8_LDA(At, 1, 1); PG8_STAGE(PG8_SA(1, 0), a3, voffA);
            PG8_BAR; PG8_WAIT_L(0); PG8_MMA(1, 0, At, B0); PG8_BAR; PG8_SCHED;
            PG8_STAGE(PG8_SB(1, 1), b3 + hstepB, voffB);
            PG8_WAIT_V(6); PG8_BAR; PG8_MMA(1, 1, At, B1); PG8_BAR;
        }
        E(acc, cur, wr, wc, fr, fq);
        if (!has_next) break;
#pragma unroll
        for (int a = 0; a < 2; ++a)
#pragma unroll
            for (int b = 0; b < 2; ++b)
#pragma unroll
                for (int m = 0; m < 4; ++m)
#pragma unroll
                    for (int n = 0; n < 2; ++n) acc[a][b][m][n] = (f32x4){0.f, 0.f, 0.f, 0.f};
        cur = nxt; cA = nA; cB = nB; ++ui;
    }
    PG8_WAIT_V(0);
    if (wr == 0) PG8_BAR;
    PG8_BAR;
#undef PG8_SA
#undef PG8_SB
#undef PG8_STAGE
#undef PG8_LDA
#undef PG8_LDB
#undef PG8_MMA
#undef PG8_WAIT_V
#undef PG8_WAIT_L
#undef PG8_BAR
#undef PG8_SCHED
}
}
using pg8::Unit;

__device__ __forceinline__ float row_rstd(const float* ssq, int row) {
  const f32x4 a = *(const f32x4*)(ssq + (size_t)row * 4) + *(const f32x4*)(ssq + (size_t)(T + row) * 4) + *(const f32x4*)(ssq + (size_t)(2 * T + row) * 4) + *(const f32x4*)(ssq + (size_t)(3 * T + row) * 4);
  return rsqrtf((a[0] + a[1] + a[2] + a[3]) * (1.0f / 1024.0f) + EPS);
}

__device__ __forceinline__ void rows_rstd8(const float* ssq, int row0, int fq, float (&rs)[2][4]) {
  f32x4 pv[2][4];
#pragma unroll
  for (int ai = 0; ai < 2; ++ai)
#pragma unroll
    for (int m = 0; m < 4; ++m) pv[ai][m] = *(const f32x4*)(ssq + ((size_t)fq * T + row0 + ai * 128 + m * 16) * 4);
#pragma unroll
  for (int ai = 0; ai < 2; ++ai)
#pragma unroll
    for (int m = 0; m < 4; ++m) {
      float t = (pv[ai][m][0] + pv[ai][m][1]) + (pv[ai][m][2] + pv[ai][m][3]);
      t += __shfl_xor(t, 16); t += __shfl_xor(t, 32);
      rs[ai][m] = rsqrtf(t * (1.0f / 1024.0f) + EPS);
    }
}
struct EpiProj {
  static constexpr bool PERM = true;
  bf16_t* proj; float* gs; const float* ssq; int smask;
  __device__ __forceinline__ void operator()(const f32x4 (&acc)[2][2][4][2], const Unit& u, int wr, int wc, int fr, int fq) const {
    const int row0 = u.pm * 256 + wr * 64 + fr, col0 = u.pn * 256 + wc * 32 + 8 * fq;
    const bool rot = (u.pn >= 12) && (u.pn < 16);
    float inv[8];
    if (rot) {
#pragma unroll
      for (int e = 0; e < 8; ++e) inv[e] = __builtin_amdgcn_exp2f(-(float)((wc * 32 + 8 * fq + e) & 63) * (13.287712379549449f / 64.0f)) * 0.15915494309189535f;
    }
    const float ksc = (u.pn >= 14) ? 0.08838834764831845f : 1.0f;
    float rsa[2][4];
    rows_rstd8(ssq, row0, fq, rsa);
#pragma unroll
    for (int ai = 0; ai < 2; ++ai) {
      float rs[4];
#pragma unroll
      for (int m = 0; m < 4; ++m) rs[m] = rsa[ai][m];
#pragma unroll
      for (int m = 0; m < 4; ++m) {
        const int row = row0 + ai * 128 + m * 16;
        if (rot) {
          const float pos = (float)(row & smask), sc = rs[m] * ksc;
          float o1[8], o2[8];
#pragma unroll
          for (int e = 0; e < 8; ++e) {
            float r = pos * inv[e]; r = r - floorf(r);
            const float sn = __builtin_amdgcn_sinf(r), cs = __builtin_amdgcn_cosf(r);
            const float t1 = acc[ai][0][m][e >> 2][e & 3] * sc, t2 = acc[ai][1][m][e >> 2][e & 3] * sc;
            o1[e] = t1 * cs - t2 * sn; o2[e] = t1 * sn + t2 * cs;
          }
          u32x4 w1, w2;
          w1.x = cvt_pk_bf16(o1[0], o1[1]); w1.y = cvt_pk_bf16(o1[2], o1[3]); w1.z = cvt_pk_bf16(o1[4], o1[5]); w1.w = cvt_pk_bf16(o1[6], o1[7]);
          w2.x = cvt_pk_bf16(o2[0], o2[1]); w2.y = cvt_pk_bf16(o2[2], o2[3]); w2.z = cvt_pk_bf16(o2[4], o2[5]); w2.w = cvt_pk_bf16(o2[6], o2[7]);
          *(u32x4*)(proj + (size_t)row * PLD + col0) = w1; *(u32x4*)(proj + (size_t)row * PLD + col0 + 128) = w2;
        } else {
#pragma unroll
          for (int bj = 0; bj < 2; ++bj) {
            const int c = col0 + bj * 128;
            f32x4 v0 = acc[ai][bj][m][0] * rs[m], v1 = acc[ai][bj][m][1] * rs[m];
            if (c < NPROJ) { u32x4 w; w.x = cvt_pk_bf16(v0[0], v0[1]); w.y = cvt_pk_bf16(v0[2], v0[3]); w.z = cvt_pk_bf16(v1[0], v1[1]); w.w = cvt_pk_bf16(v1[2], v1[3]);
              *(u32x4*)(proj + (size_t)row * PLD + c) = w; }
            if (c >= C_DT && c < C_DT + 32) { float* q = gs + (size_t)row * 32 + (c - C_DT); *(f32x4*)q = v0; *(f32x4*)(q + 4) = v1; }
            if (c >= C_MLG && c < C_MLG + 16) { float* q = gs + (size_t)T * 32 + (size_t)row * 16 + (c - C_MLG); *(f32x4*)q = v0; *(f32x4*)(q + 4) = v1; }
          }
        }
      }
    }
  }
};
struct EpiGate {
  static constexpr bool PERM = true;
  bf16_t* gate; const float* bias; const float* ssq;
  __device__ __forceinline__ void operator()(const f32x4 (&acc)[2][2][4][2], const Unit& u, int wr, int wc, int fr, int fq) const {
    const int row0 = u.pm * 256 + wr * 64 + fr, col0 = u.pn * 256 + wc * 32 + 8 * fq;
    float rs[2][4]; f32x4 bv[2][2];
#pragma unroll
    for (int bj = 0; bj < 2; ++bj) { bv[bj][0] = *(const f32x4*)(bias + col0 + bj * 128); bv[bj][1] = *(const f32x4*)(bias + col0 + bj * 128 + 4); }
    rows_rstd8(ssq, row0, fq, rs);
#pragma unroll
    for (int ai = 0; ai < 2; ++ai)
#pragma unroll
      for (int m = 0; m < 4; ++m) {
        const int row = row0 + ai * 128 + m * 16;
#pragma unroll
        for (int bj = 0; bj < 2; ++bj) {
          const int c = col0 + bj * 128;
          f32x4 v0 = acc[ai][bj][m][0] * rs[ai][m] + bv[bj][0], v1 = acc[ai][bj][m][1] * rs[ai][m] + bv[bj][1];
#pragma unroll
          for (int j = 0; j < 4; ++j) { v0[j] = sigmoidf_(v0[j]); v1[j] = sigmoidf_(v1[j]); }
          u32x4 w; w.x = cvt_pk_bf16(v0[0], v0[1]); w.y = cvt_pk_bf16(v0[2], v0[3]); w.z = cvt_pk_bf16(v1[0], v1[1]); w.w = cvt_pk_bf16(v1[2], v1[3]);
          *(u32x4*)(gate + (size_t)row * 3072 + c) = w;
        }
      }
  }
};
struct EpiBranch {
  static constexpr bool PERM = true;
  const bf16_t* gate; bf16_t* merged;
  __device__ __forceinline__ void operator()(const f32x4 (&acc)[2][2][4][2], const Unit& u, int wr, int wc, int fr, int fq) const {
    const int br = u.pn >> 2;
    const int row0 = u.pm * 256 + wr * 64 + fr, col0 = u.pn * 256 + wc * 32 + 8 * fq, mcol0 = (u.pn & 3) * 256 + wc * 32 + 8 * fq;
#pragma unroll
    for (int ai = 0; ai < 2; ++ai) {
      u32x4 gw[4][2], mw[4][2];
#pragma unroll
      for (int m = 0; m < 4; ++m)
#pragma unroll
        for (int bj = 0; bj < 2; ++bj) {
          gw[m][bj] = *(const u32x4*)(gate + (size_t)(row0 + ai * 128 + m * 16) * 3072 + col0 + bj * 128);
          mw[m][bj] = br ? *(const u32x4*)(merged + (size_t)(row0 + ai * 128 + m * 16) * 1024 + mcol0 + bj * 128) : (u32x4){0u, 0u, 0u, 0u};
        }
#pragma unroll
      for (int m = 0; m < 4; ++m) {
        const int row = row0 + ai * 128 + m * 16;
#pragma unroll
        for (int bj = 0; bj < 2; ++bj) {
          const u32x4 g = gw[m][bj], o = mw[m][bj];
          const f32x4 a0 = acc[ai][bj][m][0], a1 = acc[ai][bj][m][1];
          u32x4 w;
          w.x = cvt_pk_bf16(a0[0] * bflo(g.x) + bflo(o.x), a0[1] * bfhi(g.x) + bfhi(o.x)); w.y = cvt_pk_bf16(a0[2] * bflo(g.y) + bflo(o.y), a0[3] * bfhi(g.y) + bfhi(o.y));
          w.z = cvt_pk_bf16(a1[0] * bflo(g.z) + bflo(o.z), a1[1] * bfhi(g.z) + bfhi(o.z)); w.w = cvt_pk_bf16(a1[2] * bflo(g.w) + bflo(o.w), a1[3] * bfhi(g.w) + bfhi(o.w));
          *(u32x4*)(merged + (size_t)row * 1024 + mcol0 + bj * 128) = w;
        }
      }
    }
  }
};
struct EpiRes {
  static constexpr bool PERM = false;
  bf16_t* xb; float* ssq;
  __device__ __forceinline__ void operator()(const f32x4 (&acc)[2][2][4][2], const Unit& u, int wr, int wc, int fr, int fq) const {
    const int row0 = u.pm * 256 + wr * 64 + fr, col0 = u.pn * 256 + wc * 32 + 4 * fq;
    u32x2 xw[2][4][2][2];
#pragma unroll
    for (int ai = 0; ai < 2; ++ai)
#pragma unroll
      for (int m = 0; m < 4; ++m)
#pragma unroll
        for (int bj = 0; bj < 2; ++bj)
#pragma unroll
          for (int n = 0; n < 2; ++n) xw[ai][m][bj][n] = *(const u32x2*)(xb + (size_t)(row0 + ai * 128 + m * 16) * 1024 + col0 + bj * 128 + n * 16);
#pragma unroll
    for (int ai = 0; ai < 2; ++ai)
#pragma unroll
      for (int m = 0; m < 4; ++m) {
        const int row = row0 + ai * 128 + m * 16; float sq = 0.f;
#pragma unroll
        for (int bj = 0; bj < 2; ++bj)
#pragma unroll
          for (int n = 0; n < 2; ++n) {
            const size_t off = (size_t)row * 1024 + col0 + bj * 128 + n * 16;
            const u32x2 o = xw[ai][m][bj][n];
            f32x4 v = acc[ai][bj][m][n];
            v[0] += bflo(o.x); v[1] += bfhi(o.x); v[2] += bflo(o.y); v[3] += bfhi(o.y);
            u32x2 w; w.x = cvt_pk_bf16(v[0], v[1]); w.y = cvt_pk_bf16(v[2], v[3]);
            *(u32x2*)(xb + off) = w;
            sq += (v[0] * v[0] + v[1] * v[1]) + (v[2] * v[2] + v[3] * v[3]);
          }
        sq += __shfl_xor(sq, 16); sq += __shfl_xor(sq, 32);
        if (fq == 0) ssq[((size_t)u.pn * T + row) * 4 + wc] = sq;
      }
  }
};
struct EpiFfn {
  static constexpr bool PERM = true;
  bf16_t* hid; const float* ssq;
  __device__ __forceinline__ void operator()(const f32x4 (&acc)[2][2][4][2], const Unit& u, int wr, int wc, int fr, int fq) const {
    const int row0 = u.pm * 256 + wr * 64 + fr, hc = u.pn * 128 + wc * 32 + 8 * fq;
    float rs[2][4];
    rows_rstd8(ssq, row0, fq, rs);
#pragma unroll
    for (int ai = 0; ai < 2; ++ai)
#pragma unroll
      for (int m = 0; m < 4; ++m) {
        const int row = row0 + ai * 128 + m * 16; const float r = rs[ai][m];
        f32x4 o0, o1;
#pragma unroll
        for (int j = 0; j < 4; ++j) {
          o0[j] = siluf_(acc[ai][0][m][0][j] * r) * (acc[ai][1][m][0][j] * r);
          o1[j] = siluf_(acc[ai][0][m][1][j] * r) * (acc[ai][1][m][1][j] * r);
        }
        u32x4 w; w.x = cvt_pk_bf16(o0[0], o0[1]); w.y = cvt_pk_bf16(o0[2], o0[3]); w.z = cvt_pk_bf16(o1[0], o1[1]); w.w = cvt_pk_bf16(o1[2], o1[3]);
        *(u32x4*)(hid + (size_t)row * FF + hc) = w;
      }
  }
};

__device__ __forceinline__ int map_w1(int r) {
  if (r < 2560) return r;
  if (r < 3072) return r + 32;
  if (r < 4096) { const int isk = r >= 3584, q = r - (isk ? 3584 : 3072), t = q >> 8, w = q & 255, head = 2 * t + ((w >> 6) & 1), half = w >> 7, i = w & 63;
                  return (isk ? 6192 : 5680) + head * 128 + half * 64 + i; }
  if (r < 4608) return r - 4096 + 3104;
  if (r < 5632) return r - 4608 + 3616;
  if (r < 6656) return r - 5632 + 4640;
  if (r < 7680) return r - 6656 + 6704;
  if (r < 8704) return r - 7680 + 7728;
  if (r < 8736) return r - 8704 + 2560;
  if (r < 8752) return r - 8736 + 5664;
  return -1;
}
__device__ __forceinline__ void cvt_tile(LAS float* tl, const float* src, int sld, int k0, int n0, int nvalid, const float* scale,
                                         bf16_t* dst, int dld, int r0, int c0, int ncopy, bool w1map) {
  const int tid = opaque_tid();
#pragma unroll
  for (int it = 0; it < 2; ++it) {
    const int k = (tid >> 4) + it * 32, n4 = (tid & 15) * 4;
    f32x4 v = (f32x4){0.f, 0.f, 0.f, 0.f};
    const int sc_ = w1map ? map_w1(n0 + n4) : (n0 + n4 < nvalid ? n0 + n4 : -1);
    if (sc_ >= 0) v = *(const f32x4*)(src + (size_t)(k0 + k) * sld + sc_);
    const float s = scale ? scale[k0 + k] : 1.f;
    tl[k * 65 + n4 + 0] = v[0] * s; tl[k * 65 + n4 + 1] = v[1] * s; tl[k * 65 + n4 + 2] = v[2] * s; tl[k * 65 + n4 + 3] = v[3] * s;
  }
  __syncthreads();
  const int n = tid >> 3, k8 = (tid & 7) * 8;
  u32x4 w;
  w.x = cvt_pk_bf16(tl[(k8 + 0) * 65 + n], tl[(k8 + 1) * 65 + n]); w.y = cvt_pk_bf16(tl[(k8 + 2) * 65 + n], tl[(k8 + 3) * 65 + n]);
  w.z = cvt_pk_bf16(tl[(k8 + 4) * 65 + n], tl[(k8 + 5) * 65 + n]); w.w = cvt_pk_bf16(tl[(k8 + 6) * 65 + n], tl[(k8 + 7) * 65 + n]);
  for (int cp = 0; cp < ncopy; ++cp) *(u32x4*)(dst + (size_t)(r0 + n) * dld + c0 + cp * 1024 + k8) = w;
  __syncthreads();
}

__device__ void phase_convert(const Params& p, int layer, LAS unsigned char* lds, int parity, int first, int stride) {
  LAS float* tl = (LAS float*)lds;
  const float* gmix = p.in[2] + layer * 1024;
  const float* w_in = p.in[3] + (size_t)layer * 1024 * NPROJ;
  const float* w_gate = p.in[4] + (size_t)layer * 1024 * 3072;
  const float* w_branch = p.in[15] + (size_t)layer * 3 * 1024 * 1024;
  const float* w_out = p.in[16] + (size_t)layer * 1024 * 1024;
  const float* gffn = p.in[17] + layer * 1024;
  const float* w_fg = p.in[18] + (size_t)layer * 1024 * FF;
  const float* w_fu = p.in[19] + (size_t)layer * 1024 * FF;
  const float* w_fd = p.in[20] + (size_t)layer * FF * 1024;
  unsigned char* wb = p.ws + (parity ? WS_WB : 0);
  bf16_t* W1 = (bf16_t*)(wb + WS_W1); bf16_t* WG = (bf16_t*)(wb + WS_WG); bf16_t* W2 = (bf16_t*)(wb + WS_W2);
  bf16_t* W3 = (bf16_t*)(wb + WS_W3); bf16_t* W4 = (bf16_t*)(wb + WS_W4); bf16_t* W5 = (bf16_t*)(wb + WS_W5);
  for (int t = first; t < 6144; t += stride) {
    int i = t;
    const float* src; const float* scale = nullptr; bf16_t* dst; int sld, k0, n0, nvalid, dld, r0, ncopy = 1;
    if (i < 2240) { const int nt = i >> 4; k0 = (i & 15) * 64; n0 = nt * 64; src = w_in; sld = NPROJ; nvalid = NPROJ; scale = gmix; dst = W1; dld = 1024; r0 = n0; }
    else if ((i -= 2240) < 768) { const int nt = i >> 4; k0 = (i & 15) * 64; n0 = nt * 64; src = w_gate; sld = 3072; nvalid = 3072; scale = gmix; dst = WG; dld = 1024; r0 = n0; }
    else if ((i -= 768) < 768) { const int br = i >> 8, j = i & 255, nt = j >> 4; k0 = (j & 15) * 64; n0 = nt * 64; src = w_branch + (size_t)br * 1024 * 1024; sld = 1024; nvalid = 1024; dst = W2; dld = 1024; r0 = br * 1024 + n0; }
    else if ((i -= 768) < 256) { const int nt = i >> 4; k0 = (i & 15) * 64; n0 = nt * 64; src = w_out; sld = 1024; nvalid = 1024; dst = W3; dld = 1024; r0 = n0; }
    else if ((i -= 256) < 1408) { const int nt = i >> 4, pp = nt >> 2, half = (nt >> 1) & 1, sub = nt & 1; k0 = (i & 15) * 64; n0 = pp * 128 + sub * 64; src = half ? w_fu : w_fg; sld = FF; nvalid = FF; scale = gffn; dst = W4; dld = 1024; r0 = pp * 256 + half * 128 + sub * 64; }
    else { i -= 1408; const int nt = i / 44; k0 = (i % 44) * 64; n0 = nt * 64; src = w_fd; sld = 1024; nvalid = 1024; dst = W5; dld = FF; r0 = n0; }
    cvt_tile(tl, src, sld, k0, n0, nvalid, scale, dst, dld, r0, k0, ncopy, t < 2240);
  }
}

__device__ void phase_load_rows(const float* xin, bf16_t* xb, float* ssq) {
  const int tid_ = opaque_tid(); const int lane = tid_ & 63, wid = tid_ >> 6;
  for (int row = blockIdx.x * 8 + wid; row < T; row += gridDim.x * 8) {
    float sq = 0.f;
#pragma unroll
    for (int i = 0; i < 4; ++i) {
      const size_t off = (size_t)row * 1024 + i * 256 + lane * 4;
      const f32x4 v = *(const f32x4*)(xin + off);
      u32x2 w; w.x = cvt_pk_bf16(v[0], v[1]); w.y = cvt_pk_bf16(v[2], v[3]); *(u32x2*)(xb + off) = w;
      sq += (v[0] * v[0] + v[1] * v[1]) + (v[2] * v[2] + v[3] * v[3]);
    }
#pragma unroll
    for (int o = 1; o < 64; o <<= 1) sq += __shfl_xor(sq, o);
    if (lane < 16) ssq[((size_t)(lane >> 2) * T + row) * 4 + (lane & 3)] = lane == 0 ? sq : 0.f;
  }
}
__device__ void phase_final_norm(const bf16_t* xb, float* out, const float* ssq, const float* g) {
  const int tid_ = opaque_tid(); const int lane = tid_ & 63, wid = tid_ >> 6;
  for (int row = blockIdx.x * 8 + wid; row < T; row += gridDim.x * 8) {
    const float rs = row_rstd(ssq, row);
#pragma unroll
    for (int i = 0; i < 4; ++i) {
      const size_t off = (size_t)row * 1024 + i * 256 + lane * 4;
      const u32x2 w = *(const u32x2*)(xb + off); const f32x4 gg = *(const f32x4*)(g + i * 256 + lane * 4);
      const f32x4 v = (f32x4){bflo(w.x), bfhi(w.x), bflo(w.y), bfhi(w.y)};
      *(f32x4*)(out + off) = v * rs * gg;
    }
  }
}

__device__ void phase_conv(const bf16_t* __restrict__ proj, bf16_t* __restrict__ xc, const float* cw, const float* cb, int S) {
  const int tid_ = opaque_tid();
  const int nitems = 192 * (T / 32);
  for (int id = blockIdx.x * 512 + tid_; id < nitems; id += gridDim.x * 512) {
    const int cg = id % 192, c8 = cg * 8, t0 = (id / 192) * 32, pos0 = t0 % S;
    float wt[4][8], bs[8];
#pragma unroll
    for (int e = 0; e < 8; ++e) bs[e] = cb[c8 + e];
#pragma unroll
    for (int tau = 0; tau < 4; ++tau)
#pragma unroll
      for (int e = 0; e < 8; ++e) wt[tau][e] = cw[tau * 1536 + c8 + e];
    const bf16_t* src = proj + C_XBC + c8;
    const u32x4 zero = (u32x4){0u, 0u, 0u, 0u};
    u32x4 w0 = (pos0 >= 2) ? *(const u32x4*)(src + (size_t)(t0 - 2) * PLD) : zero;
    u32x4 w1 = (pos0 >= 1) ? *(const u32x4*)(src + (size_t)(t0 - 1) * PLD) : zero;
    u32x4 w2 = *(const u32x4*)(src + (size_t)t0 * PLD);
#pragma unroll 1
    for (int b = 0; b < 4; ++b) {
      u32x4 nx[8];
#pragma unroll
      for (int k = 0; k < 8; ++k) { const int tt = t0 + b * 8 + k + 1; nx[k] = (pos0 + b * 8 + k + 1 < S) ? *(const u32x4*)(src + (size_t)tt * PLD) : zero; }
#pragma unroll
      for (int k = 0; k < 8; ++k) {
        const u32x4 w3 = nx[k];
        float a[8];
        const unsigned r0[4] = {w0.x, w0.y, w0.z, w0.w}, r1[4] = {w1.x, w1.y, w1.z, w1.w}, r2[4] = {w2.x, w2.y, w2.z, w2.w}, r3[4] = {w3.x, w3.y, w3.z, w3.w};
#pragma unroll
        for (int q = 0; q < 4; ++q) {
          a[2 * q] = bs[2 * q] + bflo(r0[q]) * wt[0][2 * q] + bflo(r1[q]) * wt[1][2 * q] + bflo(r2[q]) * wt[2][2 * q] + bflo(r3[q]) * wt[3][2 * q];
          a[2 * q + 1] = bs[2 * q + 1] + bfhi(r0[q]) * wt[0][2 * q + 1] + bfhi(r1[q]) * wt[1][2 * q + 1] + bfhi(r2[q]) * wt[2][2 * q + 1] + bfhi(r3[q]) * wt[3][2 * q + 1];
        }
#pragma unroll
        for (int e = 0; e < 8; ++e) a[e] = siluf_(a[e]);
        u32x4 o; o.x = cvt_pk_bf16(a[0], a[1]); o.y = cvt_pk_bf16(a[2], a[3]); o.z = cvt_pk_bf16(a[4], a[5]); o.w = cvt_pk_bf16(a[6], a[7]);
        *(u32x4*)(xc + (size_t)(t0 + b * 8 + k) * 1536 + c8) = o;
        w0 = w1; w1 = w2; w2 = w3;
      }
    }
  }
}

__device__ void phase_rope(bf16_t* proj, int S) {
  const int tid_ = opaque_tid();
  const size_t total = (size_t)T * 32;
  for (size_t id = (size_t)blockIdx.x * 512 + tid_; id < total; id += (size_t)gridDim.x * 512) {
    const int t = (int)(id >> 5), hd = (int)(id >> 3) & 3, ch = (int)id & 7;
    bf16_t* src = proj + (size_t)t * PLD + hd * 128 + ch * 8;
    const u32x4 q1 = *(const u32x4*)(src + C_RTQ), q2 = *(const u32x4*)(src + C_RTQ + 64), k1 = *(const u32x4*)(src + C_RTK), k2 = *(const u32x4*)(src + C_RTK + 64);
    const float pos = (float)(t % S);
    float cs[8], sn[8];
#pragma unroll
    for (int e = 0; e < 8; ++e) {
      const float inv = __builtin_amdgcn_exp2f(-(float)(ch * 8 + e) * (13.287712379549449f / 64.0f));
      float r = pos * inv * 0.15915494309189535f; r = r - floorf(r);
      sn[e] = __builtin_amdgcn_sinf(r); cs[e] = __builtin_amdgcn_cosf(r);
    }
    const float ksc = 0.08838834764831845f;
    const unsigned qa[4] = {q1.x, q1.y, q1.z, q1.w}, qb[4] = {q2.x, q2.y, q2.z, q2.w}, ka[4] = {k1.x, k1.y, k1.z, k1.w}, kb[4] = {k2.x, k2.y, k2.z, k2.w};
    unsigned oq1[4], oq2[4], ok1[4], ok2[4];
#pragma unroll
    for (int w = 0; w < 4; ++w) {
      const float a0 = bflo(qa[w]), a1 = bfhi(qa[w]), b0 = bflo(qb[w]), b1 = bfhi(qb[w]);
      oq1[w] = cvt_pk_bf16(a0 * cs[2 * w] - b0 * sn[2 * w], a1 * cs[2 * w + 1] - b1 * sn[2 * w + 1]);
      oq2[w] = cvt_pk_bf16(a0 * sn[2 * w] + b0 * cs[2 * w], a1 * sn[2 * w + 1] + b1 * cs[2 * w + 1]);
      const float e0 = bflo(ka[w]) * ksc, e1 = bfhi(ka[w]) * ksc, g0 = bflo(kb[w]) * ksc, g1 = bfhi(kb[w]) * ksc;
      ok1[w] = cvt_pk_bf16(e0 * cs[2 * w] - g0 * sn[2 * w], e1 * cs[2 * w + 1] - g1 * sn[2 * w + 1]);
      ok2[w] = cvt_pk_bf16(e0 * sn[2 * w] + g0 * cs[2 * w], e1 * sn[2 * w + 1] + g1 * cs[2 * w + 1]);
    }
    *(u32x4*)(src + C_RTQ) = (u32x4){oq1[0], oq1[1], oq1[2], oq1[3]};
    *(u32x4*)(src + C_RTQ + 64) = (u32x4){oq2[0], oq2[1], oq2[2], oq2[3]};
    *(u32x4*)(src + C_RTK) = (u32x4){ok1[0], ok1[1], ok1[2], ok1[3]};
    *(u32x4*)(src + C_RTK + 64) = (u32x4){ok2[0], ok2[1], ok2[2], ok2[3]};
  }
}

constexpr int MXP = 272;
constexpr int MX_Q = 0, MX_K = 34816, MX_KT = 69632, MX_VT = 104448, MX_HT = 121856, MX_V = 139264, MX_N = 155648, MX_VEC = 155904, MX_END = MX_VEC + 7 * 512 + 64;
constexpr int LDS_XB = MX_END > pg8::STAGE_BYTES ? MX_END : pg8::STAGE_BYTES;
constexpr int LDS_BYTES = LDS_XB + 16;

__device__ __forceinline__ int swz(int row, int col) { return row * MXP + col * 2; }
__device__ __forceinline__ bf16x8 ldfrag(LAS const unsigned char* base, int row0, int ks, int lane) {
  const int row = row0 + (lane & 31);
  return *(LAS const bf16x8*)(base + row * MXP + (lane >> 5) * 16 + ks * 32);
}
__device__ __forceinline__ u32x4 scale_pk(u32x4 v, float s) {
  u32x4 w; w.x = cvt_pk_bf16(bflo(v.x) * s, bfhi(v.x) * s); w.y = cvt_pk_bf16(bflo(v.y) * s, bfhi(v.y) * s);
  w.z = cvt_pk_bf16(bflo(v.z) * s, bfhi(v.z) * s); w.w = cvt_pk_bf16(bflo(v.w) * s, bfhi(v.w) * s); return w;
}

template <int BR, bool DEN>
__device__ void mixer_item(const Params& p, LAS unsigned char* lds, int layer, int S, int seq, int dir, int ht) {
  const int tid = opaque_tid(), wid = __builtin_amdgcn_readfirstlane(tid >> 6), lane = tid & 63, rb = wid >> 1, cb = wid & 1;
  const bf16_t* proj = (const bf16_t*)(p.ws + WS_PROJ);
  const bf16_t* xc = (const bf16_t*)(p.ws + WS_XC);
  const float* gs = (const float*)(p.ws + WS_GS);
  bf16_t* yout = (bf16_t*)(p.ws + (dir ? WS_YB : WS_YF));
  LAS float* vC = (LAS float*)(lds + MX_VEC); LAS float* vMu = vC + 128; LAS float* vW = vC + 256; LAS float* vR = vC + 384; LAS float* vCl = vC + 512; LAS float* vVs = vC + 640; LAS float* sc = vC + 896;
  constexpr bool STAB = (BR == 1);
  int hd, vt, ocol;
  if (BR == 0) { hd = ht; vt = 0; ocol = ht * 64; } else if (DEN) { hd = ht; vt = 0; ocol = 0; } else { hd = ht >> 2; vt = ht & 3; ocol = (BR == 1 ? 1024 : 2048) + hd * 256 + vt * 64; }
  float cst_a = 0.f, cst_b = 0.f, cst_c = 0.f;
  if (BR == 0) { cst_a = -expf(p.in[8][layer * 32 + dir * 16 + hd]); cst_b = p.in[9][layer * 32 + dir * 16 + hd]; }
  if (BR == 1) { cst_b = p.in[12][layer * 16 + (2 * dir) * 4 + hd]; cst_c = p.in[12][layer * 16 + (2 * dir + 1) * 4 + hd]; }
  if (BR == 2) { cst_a = logf(1.0f - exp2f(-5.0f - (4.0f / 3.0f) * (float)hd)); }
  const int nc = S / 128;
  const int seqbase = seq * S;
  f32x16 Hacc;
#pragma unroll
  for (int j = 0; j < 16; ++j) Hacc[j] = 0.f;
  float m_st = 0.f;
  { unsigned z0 = 0u; asm volatile("" : "+v"(z0)); const u32x4 zv = (u32x4){z0, z0, z0, z0};
    for (int i = tid; i < 64 * MXP / 16; i += 512) *(LAS u32x4*)(lds + MX_HT + i * 16) = zv;
    if (tid < 16) *(LAS u32x4*)(lds + MX_N + tid * 16) = zv; }

  u32x4 ra[8], rv[2]; float rg[4] = {0.f, 0.f, 0.f, 0.f};
#define MX_ISSUE_LOADS(ci_) do { \
    const int tk_ = seqbase + (ci_) * 128; \
    { \
      _Pragma("unroll") for (int it = 0; it < 4; ++it) { const int id = it * 512 + tid, row = id >> 4, ch = id & 15; \
        if (BR == 1) { const bf16_t* src = proj + (size_t)(tk_ + row) * PLD + hd * 128 + ch * 8; ra[it] = *(const u32x4*)(src + C_MLQ); ra[4 + it] = *(const u32x4*)(src + C_MLK); } \
        else if (BR == 2) { const bf16_t* src = proj + (size_t)(tk_ + row) * PLD + (hd >> 1) * 256 + (ch >> 3) * 128 + (hd & 1) * 64 + (ch & 7) * 8; ra[it] = *(const u32x4*)(src + C_RTQ); ra[4 + it] = *(const u32x4*)(src + C_RTK); } \
        else { const bf16_t* src = xc + (size_t)(tk_ + row) * 1536 + (hd >> 3) * 128 + ch * 8; ra[it] = *(const u32x4*)(src + 1280); ra[4 + it] = *(const u32x4*)(src + 1024); } } \
    } \
    _Pragma("unroll") for (int it = 0; it < 2; ++it) { const int id = it * 512 + tid, row = id >> 3, ch = id & 7; \
      if (DEN) rv[it] = (u32x4){0x3F803F80u, 0x3F803F80u, 0x3F803F80u, 0x3F803F80u}; \
      else if (BR == 0) rv[it] = *(const u32x4*)(xc + (size_t)(tk_ + row) * 1536 + hd * 64 + ch * 8); \
      else rv[it] = *(const u32x4*)(proj + (size_t)(tk_ + row) * PLD + (BR == 1 ? C_MLV : C_RTV) + hd * 256 + vt * 64 + ch * 8); } \
    if (wid == 0 && BR != 2) { const int q0_ = dir ? 127 - 2 * lane : 2 * lane, q1_ = dir ? 126 - 2 * lane : 2 * lane + 1; \
      if (BR == 0) { rg[0] = gs[(size_t)(tk_ + q0_) * 32 + dir * 16 + hd]; rg[1] = gs[(size_t)(tk_ + q1_) * 32 + dir * 16 + hd]; } \
      else { const float* gg = gs + (size_t)T * 32; rg[0] = gg[(size_t)(tk_ + q0_) * 16 + (2 * dir + 1) * 4 + hd]; rg[1] = gg[(size_t)(tk_ + q1_) * 16 + (2 * dir + 1) * 4 + hd]; \
        rg[2] = gg[(size_t)(tk_ + q0_) * 16 + (2 * dir) * 4 + hd]; rg[3] = gg[(size_t)(tk_ + q1_) * 16 + (2 * dir) * 4 + hd]; } } \
  } while (0)
  MX_ISSUE_LOADS(dir ? nc - 1 : 0);

  for (int c = 0; c < nc; ++c) {
    const int ci = dir ? nc - 1 - c : c;
    const int tok0 = seqbase + ci * 128;
    if (wid == 0) {
      const int j0 = 2 * lane, j1 = j0 + 1;
      const int p0 = dir ? 127 - j0 : j0, p1 = dir ? 127 - j1 : j1;
      float l0, l1, b0 = 0.f, b1 = 0.f, d0 = 1.f, d1 = 1.f;
      if (BR == 0) {
        d0 = softplusf_(rg[0] + cst_b); d1 = softplusf_(rg[1] + cst_b);
        l0 = d0 * cst_a; l1 = d1 * cst_a;
      } else if (BR == 1) {
        l0 = -softplusf_(-(rg[0] + cst_c)); l1 = -softplusf_(-(rg[1] + cst_c));
        b0 = rg[2] + cst_b; b1 = rg[3] + cst_b;
      } else { l0 = cst_a; l1 = cst_a; }
      float run = l0 + l1;
#pragma unroll
      for (int o = 1; o < 64; o <<= 1) { const float t = __shfl_up(run, o); if (lane >= o) run += t; }
      const float A1 = run, A0 = run - l1;
      const float A_end = __shfl(A1, 63);
      const float c0 = b0 - A0, c1 = b1 - A1;
      float mu0, mu1, mu_end;
      if (STAB) {
        float rm = fmaxf(c0, c1);
#pragma unroll
        for (int o = 1; o < 64; o <<= 1) { const float t = __shfl_up(rm, o); if (lane >= o) rm = fmaxf(rm, t); }
        const float ex = __shfl_up(rm, 1);
        const float pm0 = lane > 0 ? fmaxf(ex, c0) : c0, pm1 = rm;
        mu0 = fmaxf(m_st, pm0); mu1 = fmaxf(m_st, pm1); mu_end = fmaxf(m_st, __shfl(pm1, 63));
      } else { mu0 = -A0; mu1 = -A1; mu_end = -A_end; }
      vC[p0] = c0; vC[p1] = c1; vMu[p0] = mu0; vMu[p1] = mu1;
      vW[p0] = __expf(c0 - mu_end); vW[p1] = __expf(c1 - mu_end);
      vR[p0] = __expf(m_st - mu0); vR[p1] = __expf(m_st - mu1);
      vCl[p0] = STAB ? __expf(-A0 - mu0) : 0.f; vCl[p1] = STAB ? __expf(-A1 - mu1) : 0.f;
      vVs[p0] = d0; vVs[p1] = d1;
      if (lane == 0) sc[0] = __expf(m_st - mu_end);
      m_st = STAB ? A_end + mu_end : 0.f;
    }
    {
#pragma unroll
      for (int it = 0; it < 4; ++it) {
        const int id = it * 512 + tid, row = id >> 4, ch = id & 15;
        *(LAS u32x4*)(lds + MX_Q + swz(row, ch * 8)) = BR == 1 ? scale_pk(ra[it], 0.08838834764831845f) : ra[it];
        *(LAS u32x4*)(lds + MX_K + swz(row, ch * 8)) = ra[4 + it];
      }
    }
#pragma unroll
    for (int it = 0; it < 2; ++it) {
      const int id = it * 512 + tid, row = id >> 3, ch = id & 7;
      *(LAS u32x4*)(lds + MX_V + row * 128 + ch * 16) = rv[it];
    }
    __syncthreads();
    {
      const int dk = tid & 127, sg = tid >> 7, dv = tid & 63, sv = tid >> 6;
      unsigned short kr[32], vr[16];
      f32x4 w4[8], vs4[4];
#pragma unroll
      for (int i = 0; i < 32; ++i) kr[i] = *(LAS const bf16_t*)(lds + MX_K + swz(sg * 32 + i, dk));
#pragma unroll
      for (int i = 0; i < 16; ++i) vr[i] = *(LAS const bf16_t*)(lds + MX_V + (sv * 16 + i) * 128 + dv * 2);
#pragma unroll
      for (int i = 0; i < 8; ++i) w4[i] = *(LAS const f32x4*)(vW + sg * 32 + i * 4);
      if (BR == 0) {
#pragma unroll
        for (int i = 0; i < 4; ++i) vs4[i] = *(LAS const f32x4*)(vVs + sv * 16 + i * 4);
      }
      __builtin_amdgcn_sched_barrier(0);
#pragma unroll
      for (int s8 = 0; s8 < 4; ++s8) {
        float f[8];
#pragma unroll
        for (int e = 0; e < 8; ++e) f[e] = bf2f(kr[s8 * 8 + e]) * w4[s8 * 2 + (e >> 2)][e & 3];
        u32x4 w; w.x = cvt_pk_bf16(f[0], f[1]); w.y = cvt_pk_bf16(f[2], f[3]); w.z = cvt_pk_bf16(f[4], f[5]); w.w = cvt_pk_bf16(f[6], f[7]);
        *(LAS u32x4*)(lds + MX_KT + swz(dk, sg * 32 + s8 * 8)) = w;
      }
#pragma unroll
      for (int s8 = 0; s8 < 2; ++s8) {
        float f[8];
#pragma unroll
        for (int e = 0; e < 8; ++e) { f[e] = bf2f(vr[s8 * 8 + e]); if (BR == 0) f[e] *= vs4[s8 * 2 + (e >> 2)][e & 3]; }
        u32x4 w; w.x = cvt_pk_bf16(f[0], f[1]); w.y = cvt_pk_bf16(f[2], f[3]); w.z = cvt_pk_bf16(f[4], f[5]); w.w = cvt_pk_bf16(f[6], f[7]);
        *(LAS u32x4*)(lds + MX_VT + swz(dv, sv * 16 + s8 * 8)) = w;
      }
    }
    __syncthreads();
    f32x16 S0, S1, QH;
#pragma unroll
    for (int j = 0; j < 16; ++j) { S0[j] = 0.f; S1[j] = 0.f; QH[j] = 0.f; }
    {
      const float dec = sc[0];
#pragma unroll
      for (int j = 0; j < 16; ++j) { Hacc[j] *= dec; }
      bf16x8 fa[2], fb0[2], fb1[2], fhb[2], fka[2], fvb[2];
      fa[0] = ldfrag(lds + MX_Q, 32 * rb, 0, lane); fb0[0] = ldfrag(lds + MX_K, 64 * cb, 0, lane); fb1[0] = ldfrag(lds + MX_K, 64 * cb + 32, 0, lane);
      fhb[0] = ldfrag(lds + MX_HT, 32 * cb, 0, lane); fka[0] = ldfrag(lds + MX_KT, 32 * rb, 0, lane); fvb[0] = ldfrag(lds + MX_VT, 32 * cb, 0, lane);
#pragma unroll
      for (int ks = 0; ks < 8; ++ks) {
        const int cur = ks & 1, nxt = cur ^ 1;
        if (ks < 7) {
          fa[nxt] = ldfrag(lds + MX_Q, 32 * rb, ks + 1, lane); fb0[nxt] = ldfrag(lds + MX_K, 64 * cb, ks + 1, lane); fb1[nxt] = ldfrag(lds + MX_K, 64 * cb + 32, ks + 1, lane);
          fhb[nxt] = ldfrag(lds + MX_HT, 32 * cb, ks + 1, lane); fka[nxt] = ldfrag(lds + MX_KT, 32 * rb, ks + 1, lane); fvb[nxt] = ldfrag(lds + MX_VT, 32 * cb, ks + 1, lane);
        }
        __builtin_amdgcn_sched_barrier(0);
        S0 = __builtin_amdgcn_mfma_f32_32x32x16_bf16(fa[cur], fb0[cur], S0, 0, 0, 0);
        S1 = __builtin_amdgcn_mfma_f32_32x32x16_bf16(fa[cur], fb1[cur], S1, 0, 0, 0);
        QH = __builtin_amdgcn_mfma_f32_32x32x16_bf16(fa[cur], fhb[cur], QH, 0, 0, 0);
        Hacc = __builtin_amdgcn_mfma_f32_32x32x16_bf16(fka[cur], fvb[cur], Hacc, 0, 0, 0);
        __builtin_amdgcn_sched_barrier(0);
      }
    }
    __syncthreads();
    { const int cn = c + 1 < nc ? c + 1 : c; MX_ISSUE_LOADS(dir ? nc - 1 - cn : cn); }
    {
      const int sA = 64 * cb + (lane & 31), sB = sA + 32;
      const float cA = vC[sA], cB = vC[sB];
      float mu16[16];
#pragma unroll
      for (int j = 0; j < 16; ++j) mu16[j] = vMu[32 * rb + 8 * (j >> 2) + 4 * (lane >> 5) + (j & 3)];
      __builtin_amdgcn_sched_barrier(0);
#pragma unroll
      for (int j = 0; j < 16; ++j) {
        const int t = 32 * rb + 8 * (j >> 2) + 4 * (lane >> 5) + (j & 3);
        const float mu = mu16[j];
        bool okA, okB;
        if (dir == 0) { okA = sA <= t; okB = sB <= t; } else if (BR == 2) { okA = sA > t; okB = sB > t; } else { okA = sA >= t; okB = sB >= t; }
        const float pa = okA ? S0[j] * __expf(cA - mu) : 0.f, pb = okB ? S1[j] * __expf(cB - mu) : 0.f;
        *(LAS bf16_t*)(lds + MX_Q + swz(t, sA)) = f2bf(pa);
        *(LAS bf16_t*)(lds + MX_Q + swz(t, sB)) = f2bf(pb);
      }
#pragma unroll
      for (int g4 = 0; g4 < 4; ++g4) {
        const int dk0 = 32 * rb + 8 * g4 + 4 * (lane >> 5), dvr = 32 * cb + (lane & 31);
        u32x2 w; w.x = cvt_pk_bf16(Hacc[4 * g4 + 0], Hacc[4 * g4 + 1]); w.y = cvt_pk_bf16(Hacc[4 * g4 + 2], Hacc[4 * g4 + 3]);
        *(LAS u32x2*)(lds + MX_HT + swz(dvr, dk0)) = w;
      }
    }
    __syncthreads();
    {
      float rsc[16];
#pragma unroll
      for (int j = 0; j < 16; ++j) { const int t = 32 * rb + 8 * (j >> 2) + 4 * (lane >> 5) + (j & 3); rsc[j] = vR[t]; QH[j] *= rsc[j]; }
      bf16x8 pa[2], pv[2];
      pa[0] = ldfrag(lds + MX_Q, 32 * rb, 0, lane); pv[0] = ldfrag(lds + MX_VT, 32 * cb, 0, lane);
#pragma unroll
      for (int ks = 0; ks < 8; ++ks) {
        const int cur = ks & 1, nxt = cur ^ 1;
        if (ks < 7) { pa[nxt] = ldfrag(lds + MX_Q, 32 * rb, ks + 1, lane); pv[nxt] = ldfrag(lds + MX_VT, 32 * cb, ks + 1, lane); }
        __builtin_amdgcn_sched_barrier(0);
        QH = __builtin_amdgcn_mfma_f32_32x32x16_bf16(pa[cur], pv[cur], QH, 0, 0, 0);
        __builtin_amdgcn_sched_barrier(0);
      }
#pragma unroll
      for (int j = 0; j < 16; ++j) {
        const int t = 32 * rb + 8 * (j >> 2) + 4 * (lane >> 5) + (j & 3);
        const float y = QH[j];
        if (DEN) { if (cb == 0 && (lane & 31) == 0) { float* dp = (float*)(p.ws + WS_DEN) + (((size_t)(dir * 4 + hd) * T) + tok0 + t) * 2; dp[0] = y; dp[1] = vCl[t]; } }
        else yout[(size_t)(tok0 + t) * 3072 + ocol + 32 * cb + (lane & 31)] = f2bf(y);
      }
    }
    __syncthreads();
  }
}

#undef MX_ISSUE_LOADS
__device__ void phase_mixer(const Params& p, LAS unsigned char* lds, int layer, int S, int conv_layer, int conv_parity) {
  const int nseq = T / S, nitems = nseq * 2 * 52;
  for (int it = blockIdx.x; it < nitems; it += gridDim.x) {
    const int ht_ord = it / (nseq * 2), rem = it % (nseq * 2), seq = rem >> 1, dir = rem & 1;
#ifdef ONLY_BR
    mixer_item<ONLY_BR, false>(p, lds, layer, S, seq, dir, ht_ord & 15);
#else
    if (ht_ord < 16) mixer_item<1, false>(p, lds, layer, S, seq, dir, ht_ord);
    else if (ht_ord < 20) mixer_item<1, true>(p, lds, layer, S, seq, dir, ht_ord - 16);
    else if (ht_ord < 36) mixer_item<2, false>(p, lds, layer, S, seq, dir, ht_ord - 20);
    else mixer_item<0, false>(p, lds, layer, S, seq, dir, ht_ord - 36);
#endif
  }
  if (conv_layer >= 0) {
    const int G = gridDim.x, rem = nitems % G, nconv = G - rem;
    if ((int)blockIdx.x >= rem) phase_convert(p, conv_layer, lds, conv_parity, (int)blockIdx.x - rem, nconv);
  }
}

__device__ void phase_post(const Params& p, int layer) {
  const int tid_ = opaque_tid(); const int lane = tid_ & 63, wid = tid_ >> 6;
  const bf16_t* proj = (const bf16_t*)(p.ws + WS_PROJ); const bf16_t* xc = (const bf16_t*)(p.ws + WS_XC);
  const bf16_t* yf = (const bf16_t*)(p.ws + WS_YF); const bf16_t* yb = (const bf16_t*)(p.ws + WS_YB);
  const float* den = (const float*)(p.ws + WS_DEN);
  bf16_t* act = (bf16_t*)(p.ws + WS_PROJ) + ACT_COL;
  const float* dsk = p.in[10] + layer * 16; const float* g_ssd = p.in[11] + layer * 1024; const float* g_ml = p.in[13] + layer * 1024; const float* g_rt = p.in[14] + layer * 1024;
  for (int row = blockIdx.x * 8 + wid; row < T; row += gridDim.x * 8) {
    u32x4 wf[3][2], wb[3][2], wg[3][2], wx[2]; float dn[2][4];
#pragma unroll
    for (int br = 0; br < 3; ++br)
#pragma unroll
      for (int k = 0; k < 2; ++k) {
        const int c = br * 1024 + k * 512 + lane * 8;
        wf[br][k] = *(const u32x4*)(yf + (size_t)row * 3072 + c); wb[br][k] = *(const u32x4*)(yb + (size_t)row * 3072 + c);
        const int gcol = (br == 0 ? C_Z : (br == 1 ? C_MLO : C_RTG)) + k * 512 + lane * 8;
        wg[br][k] = *(const u32x4*)(proj + (size_t)row * PLD + gcol);
      }
#pragma unroll
    for (int k = 0; k < 2; ++k) {
      wx[k] = *(const u32x4*)(xc + (size_t)row * 1536 + k * 512 + lane * 8);
      const int h = k * 2 + (lane >> 5);
      const float* df = den + (((size_t)(0 * 4 + h) * T) + row) * 2; const float* db = den + (((size_t)(1 * 4 + h) * T) + row) * 2;
      dn[k][0] = df[0]; dn[k][1] = df[1]; dn[k][2] = db[0]; dn[k][3] = db[1];
    }
#pragma unroll
    for (int br = 0; br < 3; ++br) {
      float y[2][8], gt[2][8], sq[2];
#pragma unroll
      for (int k = 0; k < 2; ++k) {
        const unsigned aa[4] = {wf[br][k].x, wf[br][k].y, wf[br][k].z, wf[br][k].w}, bb[4] = {wb[br][k].x, wb[br][k].y, wb[br][k].z, wb[br][k].w}, gg[4] = {wg[br][k].x, wg[br][k].y, wg[br][k].z, wg[br][k].w};
        float nf = 1.f, nb = 1.f;
        if (br == 1) { nf = 1.0f / fmaxf(fabsf(dn[k][0]), dn[k][1]); nb = 1.0f / fmaxf(fabsf(dn[k][2]), dn[k][3]); }
#pragma unroll
        for (int w = 0; w < 4; ++w) {
          y[k][2 * w] = bflo(aa[w]) * nf + bflo(bb[w]) * nb; y[k][2 * w + 1] = bfhi(aa[w]) * nf + bfhi(bb[w]) * nb;
          gt[k][2 * w] = bflo(gg[w]); gt[k][2 * w + 1] = bfhi(gg[w]);
        }
        if (br == 0) {
          const float dd = dsk[k * 8 + (lane >> 3)];
          const unsigned xx[4] = {wx[k].x, wx[k].y, wx[k].z, wx[k].w};
#pragma unroll
          for (int w = 0; w < 4; ++w) { y[k][2 * w] += bflo(xx[w]) * dd; y[k][2 * w + 1] += bfhi(xx[w]) * dd; }
#pragma unroll
          for (int e = 0; e < 8; ++e) y[k][e] *= siluf_(gt[k][e]);
        }
        float q = 0.f;
#pragma unroll
        for (int e = 0; e < 8; ++e) q += y[k][e] * y[k][e];
        q += __shfl_xor(q, 1); q += __shfl_xor(q, 2); q += __shfl_xor(q, 4); q += __shfl_xor(q, 8); q += __shfl_xor(q, 16);
        sq[k] = q;
      }
      float rs[2];
      if (br == 0) { float t = sq[0] + sq[1]; t += __shfl_xor(t, 32); rs[0] = rs[1] = rsqrtf(t * (1.0f / 1024.0f) + EPS); }
      else { rs[0] = rsqrtf(sq[0] * (1.0f / 256.0f) + EPS); rs[1] = rsqrtf(sq[1] * (1.0f / 256.0f) + EPS); }
#pragma unroll
      for (int k = 0; k < 2; ++k) {
        const float* gn = (br == 0 ? g_ssd : (br == 1 ? g_ml : g_rt)) + k * 512 + lane * 8;
        const f32x4 g0 = *(const f32x4*)gn, g1 = *(const f32x4*)(gn + 4);
        unsigned o[4];
#pragma unroll
        for (int e = 0; e < 8; e += 2) {
          float v0 = y[k][e] * rs[k] * (e < 4 ? g0[e] : g1[e - 4]), v1 = y[k][e + 1] * rs[k] * (e < 4 ? g0[e + 1] : g1[e - 3]);
          if (br == 1) { v0 *= sigmoidf_(gt[k][e]); v1 *= sigmoidf_(gt[k][e + 1]); }
          if (br == 2) { v0 *= siluf_(gt[k][e]); v1 *= siluf_(gt[k][e + 1]); }
          o[e >> 1] = cvt_pk_bf16(v0, v1);
        }
        *(u32x4*)(act + (size_t)row * PLD + br * 1024 + k * 512 + lane * 8) = (u32x4){o[0], o[1], o[2], o[3]};
      }
    }
  }
}

#ifndef PH_MASK
#define PH_MASK 0xFFFF
#endif
#ifndef REP_SYNC
#define REP_SYNC 1
#endif
#ifndef REP_MIX
#define REP_MIX 1
#endif
#ifndef REP_G1
#define REP_G1 1
#endif
#ifndef REP_MISC
#define REP_MISC 1
#endif
#ifndef REP_G2
#define REP_G2 1
#endif
#ifndef REP_G4
#define REP_G4 1
#endif
#define XB_TMO      128
#define XB_XCNT(j)  (256  + 64 * (j))
#define XB_XSUB(j)  (1280 + 64 * (j))
#define XB_XGEN(j)  (2304 + 64 * (j))
#define XB_TOP      3328
#define XB_TOPGEN   3392
#define XCD_BAR_WORDS 3456
#define XB_SPIN_CAP (1u << 22)

__device__ __forceinline__ unsigned xb_ld(unsigned* p)              { return __hip_atomic_load(p, __ATOMIC_RELAXED, __HIP_MEMORY_SCOPE_AGENT); }
__device__ __forceinline__ unsigned xb_add(unsigned* p, unsigned v) { return __hip_atomic_fetch_add(p, v, __ATOMIC_RELAXED, __HIP_MEMORY_SCOPE_AGENT); }
__device__ __forceinline__ unsigned xb_xcc_id() { return (unsigned)__builtin_amdgcn_s_getreg((3 << 11) | 20) & 0xFu; }
#define XB_SPIN(cond, bar) do { unsigned _sp = 0; while (cond) { __builtin_amdgcn_s_sleep(1); \
    if ((++_sp & 255u) == 0u) { if (xb_ld(&(bar)[XB_TMO])) break; if (_sp > XB_SPIN_CAP) { atomicAdd(&(bar)[XB_TMO], 1u); break; } } } } while (0)
struct XcdBarrier { unsigned* bar; unsigned x; volatile LAS unsigned* st; };
__device__ __forceinline__ XcdBarrier xcd_barrier_post(unsigned* bar, volatile LAS unsigned* st) {
    XcdBarrier b; b.bar = bar; b.x = xb_xcc_id(); b.st = st;
    if (threadIdx.x == 0) (void)xb_add(&bar[XB_XCNT(b.x)], 1u);
    return b;
}
__device__ __forceinline__ void xcd_barrier_complete(unsigned* bar, unsigned x, unsigned& nloc, unsigned& nx) {
    const unsigned G = gridDim.x * gridDim.y * gridDim.z;
    unsigned sum, cnt, mine, sp = 0u;
    for (;;) {
        sum = 0u; cnt = 0u; mine = 0u;
#pragma unroll
        for (unsigned j = 0; j < 16; ++j) { const unsigned c = xb_ld(&bar[XB_XCNT(j)]); sum += c; cnt += (c > 0u) ? 1u : 0u; mine = (j == x) ? c : mine; }
        if (sum == G) break;
        __builtin_amdgcn_s_sleep(1);
        if ((++sp & 255u) == 0u) { if (xb_ld(&bar[XB_TMO])) break; if (sp > XB_SPIN_CAP) { atomicAdd(&bar[XB_TMO], 1u); break; } }
    }
    nloc = mine > 0u ? mine : 1u; nx = cnt > 0u ? cnt : 1u;
}
__device__ __forceinline__ void xcd_barrier(const XcdBarrier& b) {
    asm volatile("s_waitcnt vmcnt(0)" ::: "memory");
    __syncthreads();
    if (threadIdx.x == 0) {
        unsigned* bar = b.bar;
        __builtin_amdgcn_s_waitcnt(0);
        unsigned nloc = b.st[0], nx = b.st[1];
        if (nloc == 0u) { xcd_barrier_complete(bar, b.x, nloc, nx); b.st[0] = nloc; b.st[1] = nx; }
        const unsigned old = xb_add(&bar[XB_XSUB(b.x)], 1u);
        const unsigned gen = old / nloc;
        if (old + 1u == (gen + 1u) * nloc) {
            __builtin_amdgcn_fence(__ATOMIC_RELEASE, "agent");
            asm volatile("s_waitcnt vmcnt(0)" ::: "memory");
            const unsigned og = xb_add(&bar[XB_TOP], 1u);
            const unsigned tg = og / nx;
            if (og + 1u == (tg + 1u) * nx) xb_add(&bar[XB_TOPGEN], 1u);
            else XB_SPIN(xb_ld(&bar[XB_TOPGEN]) == tg, bar);
            __builtin_amdgcn_fence(__ATOMIC_ACQUIRE, "agent");
            xb_add(&bar[XB_XGEN(b.x)], 1u);
            asm volatile("s_waitcnt vmcnt(0)" ::: "memory");
        } else {
            XB_SPIN(xb_ld(&bar[XB_XGEN(b.x)]) == gen, bar);
            __builtin_amdgcn_fence(__ATOMIC_ACQUIRE, "agent");
            asm volatile("s_waitcnt vmcnt(0)" ::: "memory");
        }
    }
    __syncthreads();
}
#define GSYNC() do { for (int r_ = 0; r_ < REP_SYNC; ++r_) { XcdBarrier xb_; xb_.bar = (unsigned*)(p.ws + WS_BAR); xb_.x = xb_xcc_id(); xb_.st = (volatile LAS unsigned*)(lds + LDS_XB); xcd_barrier(xb_); } } while (0)
__global__ void __launch_bounds__(512, 2) fwd_megakernel(Params p) {
  extern __shared__ __attribute__((aligned(16))) unsigned char smem[];
  LAS unsigned char* lds = (LAS unsigned char*)smem;
  cg::grid_group grid = cg::this_grid();
  if (threadIdx.x < 4) ((LAS unsigned*)(lds + LDS_XB))[threadIdx.x] = 0u;
  __syncthreads();
  (void)xcd_barrier_post((unsigned*)(p.ws + WS_BAR), (volatile LAS unsigned*)(lds + LDS_XB));
  grid.sync();
  const int G = gridDim.x, bid = blockIdx.x;
#define WSP(T_, off) ((T_*)(p.ws + (off)))
  for (int pl = 0; pl < 12; ++pl) {
    int pass = pl >> 2, layer = pl & 3;
    asm volatile("" : "+s"(pass), "+s"(layer));
    const int S = pass == 0 ? 4096 : 8192;
    {
      if (pl == 0) phase_convert(p, 0, lds, 0, (int)blockIdx.x, (int)gridDim.x);
      unsigned char* wcur = p.ws + ((pl & 1) ? WS_WB : 0);
      if (layer == 0) {
        if ((PH_MASK & 2) && pass > 0) phase_final_norm(WSP(bf16_t, WS_XB), p.out + (size_t)(pass - 1) * T * 1024, WSP(float, WS_SSQ), p.in[21]);
        GSYNC();
        if (PH_MASK & 2) phase_load_rows(pass == 0 ? p.in[0] : p.in[1] + (size_t)(pass - 1) * T * 1024, WSP(bf16_t, WS_XB), WSP(float, WS_SSQ));
      }
      GSYNC();
      for (int r_ = 0; r_ < REP_G1; ++r_) if (PH_MASK & 4) { pg8::Gemm g{WSP(bf16_t, WS_XB), (bf16_t*)(wcur + WS_W1), T, PLD, 1024, 1024, 1 << 20, 0}; pg8::StaticOrder so; so.init(T, PLD, G, bid); EpiProj E{WSP(bf16_t, WS_PROJ), WSP(float, WS_GS), WSP(float, WS_SSQ), S - 1}; pg8::gemm_phase(lds, g, so, E); }
      GSYNC();
      for (int r_ = 0; r_ < REP_MISC; ++r_) if (PH_MASK & 8) phase_conv(WSP(bf16_t, WS_PROJ), WSP(bf16_t, WS_XC), p.in[6] + layer * 4 * 1536, p.in[7] + layer * 1536, S);
      GSYNC();
      for (int r_ = 0; r_ < REP_MIX; ++r_) if (PH_MASK & 16) phase_mixer(p, lds, layer, S, pl < 11 ? ((pl + 1) & 3) : -1, (pl + 1) & 1);
      GSYNC();
      for (int ph_ = 0; ph_ < 2; ++ph_) {
        if (((ph_ ^ (bid >> 3)) & 1) != 0) { for (int r_ = 0; r_ < REP_MISC; ++r_) if (PH_MASK & 32) phase_post(p, layer); }
        else { for (int r2_ = 0; r2_ < REP_G2; ++r2_) if (PH_MASK & 64) { pg8::Gemm g{WSP(bf16_t, WS_XB), (bf16_t*)(wcur + WS_WG), T, 3072, 1024, 1024, 1 << 20, 0}; pg8::StaticOrder so; so.init(T, 3072, G, bid); EpiGate E{WSP(bf16_t, WS_GATE), p.in[5] + layer * 3072, WSP(float, WS_SSQ)}; pg8::gemm_phase(lds, g, so, E); } }
      }
      GSYNC();
      if (PH_MASK & 128) { pg8::Gemm g{WSP(bf16_t, WS_PROJ) + ACT_COL, (bf16_t*)(wcur + WS_W2), T, 3072, 1024, PLD, 4, 1024}; pg8::BranchOrder so; so.init(T, G, bid); EpiBranch E{WSP(bf16_t, WS_GATE), WSP(bf16_t, WS_GATED)}; pg8::gemm_phase(lds, g, so, E); }
      GSYNC();
      if (PH_MASK & 256) { pg8::Gemm g{WSP(bf16_t, WS_GATED), (bf16_t*)(wcur + WS_W3), T, 1024, 1024, 1024, 1 << 20, 0}; pg8::StaticOrder so; so.init(T, 1024, G, bid); EpiRes E{WSP(bf16_t, WS_XB), WSP(float, WS_SSQ)}; pg8::gemm_phase(lds, g, so, E); }
      GSYNC();
      for (int r4_ = 0; r4_ < REP_G4; ++r4_) if (PH_MASK & 512) { pg8::Gemm g{WSP(bf16_t, WS_XB), (bf16_t*)(wcur + WS_W4), T, 5632, 1024, 1024, 1 << 20, 0}; pg8::StaticOrder so; so.init(T, 5632, G, bid); EpiFfn E{WSP(bf16_t, WS_HID), WSP(float, WS_SSQ)}; pg8::gemm_phase(lds, g, so, E); }
      GSYNC();
      if (PH_MASK & 1024) { pg8::Gemm g{WSP(bf16_t, WS_HID), (bf16_t*)(wcur + WS_W5), T, 1024, FF, FF, 1 << 20, 0}; pg8::StaticOrder so; so.init(T, 1024, G, bid); EpiRes E{WSP(bf16_t, WS_XB), WSP(float, WS_SSQ)}; pg8::gemm_phase(lds, g, so, E); }
      GSYNC();
    }
  }
  phase_final_norm(WSP(bf16_t, WS_XB), p.out + (size_t)2 * T * 1024, WSP(float, WS_SSQ), p.in[21]);
}

extern "C" void kernel_launch(void* const* d_in, const int* in_sizes, int n_in, void* d_out, int out_size, void* d_ws, size_t ws_size, hipStream_t stream) {
  static int grid_blocks = 0;
  if (!grid_blocks) {
    int dev = 0, cus = 0, per_cu = 0;
    (void)hipGetDevice(&dev);
    (void)hipDeviceGetAttribute(&cus, hipDeviceAttributeMultiprocessorCount, dev);
    if (hipFuncSetAttribute((const void*)fwd_megakernel, hipFuncAttributeMaxDynamicSharedMemorySize, LDS_BYTES) != hipSuccess) fprintf(stderr, "hipFuncSetAttribute failed\n");
    if (hipOccupancyMaxActiveBlocksPerMultiprocessor(&per_cu, (const void*)fwd_megakernel, 512, LDS_BYTES) != hipSuccess || per_cu < 1) { fprintf(stderr, "occupancy query: %d\n", per_cu); per_cu = 1; }
    (void)hipGetLastError();
    grid_blocks = cus * per_cu;
    if (ws_size < WS_TOTAL || n_in != 22) { fprintf(stderr, "kernel_launch: workspace %zu < %zu or n_in %d\n", ws_size, (size_t)WS_TOTAL, n_in); }
  }
  Params p{};
  for (int i = 0; i < 22; ++i) p.in[i] = (const float*)d_in[i];
  p.out = (float*)d_out; p.ws = (unsigned char*)d_ws;
  (void)hipMemsetAsync((unsigned char*)d_ws + WS_BAR, 0, XCD_BAR_WORDS * 4, stream);
  void* args[] = {&p};
  hipError_t e = hipLaunchCooperativeKernel((const void*)fwd_megakernel, dim3(grid_blocks), dim3(512), args, LDS_BYTES, stream);
  if (e != hipSuccess) fprintf(stderr, "cooperative launch failed: %s (grid %d)\n", hipGetErrorString(e), grid_blocks);
}
```

```cpp
#include <hip/hip_runtime.h>
#include <hip/hip_cooperative_groups.h>
#include <cstdio>
namespace cg = cooperative_groups;
#define LAS __attribute__((address_space(3)))
typedef unsigned short bf16_t;
typedef short bf16x8 __attribute__((ext_vector_type(8)));
typedef float f32x4 __attribute__((ext_vector_type(4)));
typedef float f32x16 __attribute__((ext_vector_type(16)));
typedef unsigned u32x4 __attribute__((ext_vector_type(4)));
typedef unsigned u32x2 __attribute__((ext_vector_type(2)));

constexpr int D = 1024, T = 16384, FF = 2816, NPROJ = 8752, PLD = 8960;
constexpr int C_Z = 0, C_XBC = 1024, C_MLQ = 2560, C_RTQ = 3072, C_RTK = 3584, C_MLK = 4096, C_MLV = 4608, C_MLO = 5632, C_RTV = 6656, C_RTG = 7680, C_DT = 8704, C_MLG = 8736;
constexpr float EPS = 1e-6f;

constexpr size_t WS_W1 = 0;
constexpr size_t WS_WG = WS_W1 + (size_t)PLD * 1024 * 2;
constexpr size_t WS_W2 = WS_WG + (size_t)3072 * 1024 * 2;
constexpr size_t WS_W3 = WS_W2 + (size_t)3072 * 1024 * 2;
constexpr size_t WS_W4 = WS_W3 + (size_t)1024 * 3072 * 2;
constexpr size_t WS_W5 = WS_W4 + (size_t)5632 * 1024 * 2;
constexpr size_t WS_XB = WS_W5 + (size_t)1024 * FF * 2;
constexpr size_t WS_SSQ = WS_XB + (size_t)T * 1024 * 2;
constexpr size_t WS_GS = WS_SSQ + (size_t)T * 16 * 4;
constexpr size_t WS_PROJ = WS_GS + (size_t)T * 48 * 4;
constexpr size_t WS_XC = WS_PROJ + (size_t)T * PLD * 2;
constexpr size_t WS_YF = WS_XC + (size_t)T * 1536 * 2;
constexpr size_t WS_YB = WS_YF + (size_t)T * 3072 * 2;
constexpr size_t WS_ACT = WS_YB + (size_t)T * 3072 * 2;
constexpr size_t WS_END = WS_ACT + (size_t)T * 3072 * 2;
constexpr size_t WS_HID = WS_PROJ;
constexpr size_t WS_GATE = WS_ACT;
constexpr int ACT_COL = 1024;
constexpr size_t WS_GATED = WS_YF;
constexpr size_t WS_BAR = WS_END;
constexpr size_t WS_WB = WS_END + 16384;
constexpr size_t WS_DEN = WS_WB + WS_XB;
constexpr size_t WS_TOTAL = WS_DEN + (size_t)2 * 4 * T * 2 * 4;

struct Params {
  const float* in[22];
  float* out;
  unsigned char* ws;
};

__device__ __forceinline__ int opaque_tid() { int t = threadIdx.x; asm volatile("" : "+v"(t)); return t; }
typedef __bf16 bf16x2_t __attribute__((ext_vector_type(2)));
typedef float f32x2_t __attribute__((ext_vector_type(2)));
__device__ __forceinline__ unsigned cvt_pk_bf16(float lo, float hi) { const f32x2_t v = {lo, hi}; const bf16x2_t b = __builtin_convertvector(v, bf16x2_t); return __builtin_bit_cast(unsigned, b); }
__device__ __forceinline__ bf16_t f2bf(float f) { return (bf16_t)(cvt_pk_bf16(f, 0.f) & 0xffffu); }
__device__ __forceinline__ float bf2f(bf16_t b) { return __uint_as_float(((unsigned)b) << 16); }
__device__ __forceinline__ float bflo(unsigned w) { return __uint_as_float(w << 16); }
__device__ __forceinline__ float bfhi(unsigned w) { return __uint_as_float(w & 0xffff0000u); }
__device__ __forceinline__ float sigmoidf_(float x) { return __builtin_amdgcn_rcpf(1.f + __expf(-x)); }
__device__ __forceinline__ float siluf_(float x) { return x * __builtin_amdgcn_rcpf(1.f + __expf(-x)); }
__device__ __forceinline__ float softplusf_(float x) {
  const float e = __expf(fminf(x, 20.f));
  const float sp = e < 2e-3f ? e * (1.f - 0.5f * e + 0.33333334f * e * e) : __logf(1.f + e);
  return x > 20.f ? x : sp;
}

namespace pg8 {
constexpr int BM = 256, BK = 64, HALF = 128, HTB = HALF * BK * 2, STAGE_BYTES = 8 * HTB, NXCD = 8, WGM = 8;
__host__ __device__ __forceinline__ int lds_byte(int r, int c) { const int st = (r >> 4) * 2 + (c >> 5), rr = r & 15, cc = c & 31, ob = rr * 64 + cc * 2; return st * 1024 + (ob ^ (((ob >> 9) & 1) << 5)); }
__host__ __device__ __forceinline__ void stage_rc(int b, int& R, int& C) { const int st = b / 1024, sb = b % 1024, swz = sb ^ (((sb >> 9) & 1) << 5); R = (st >> 1) * 16 + swz / 64; C = (st & 1) * 32 + (swz % 64) / 2; }
__host__ __device__ __forceinline__ int perm32(int rho) { const int n = rho >> 4, i = rho & 15; return 8 * (i >> 2) + 4 * n + (i & 3); }
struct Unit { int pm, pn; };
struct Gemm { const bf16_t* A; const bf16_t* Bt; int M, N, K, lda; int asel_div; int asel_stride; };
struct StaticOrder {
    int nM, nN, nwg, G, c;
    __device__ void init(int M, int N, int G_, int c_) { nM = M / BM; nN = N / BM; nwg = nM * nN; G = G_; c = c_; }
    __device__ bool next(int i, Unit& u) const {
        const long L = (long)i * G + c; if (L >= nwg) return false;
        int wgid = (int)L; { const int q = nwg / NXCD, r = nwg % NXCD, xcd = wgid % NXCD, off = wgid / NXCD; wgid = (xcd < r ? xcd * (q + 1) : r * (q + 1) + (xcd - r) * q) + off; }
        const int nig = WGM * nN, gid = wgid / nig, fm = gid * WGM, gsz = (nM - fm) < WGM ? (nM - fm) : WGM;
        u.pm = fm + ((wgid % nig) % gsz); u.pn = (wgid % nig) / gsz; return true;
    }
};

struct BranchOrder {
    StaticOrder so;
    __device__ void init(int M, int G_, int c_) { so.init(M, 1024, G_, c_); }
    __device__ bool next(int i, Unit& u) const { Unit t; const int q = i / 3; if (!so.next(q, t)) return false; u.pm = t.pm; u.pn = (i - 3 * q) * 4 + t.pn; return true; }
};
template <class Epi, class Sched>
__device__ __forceinline__ void gemm_phase(LAS unsigned char* lds, const Gemm g, const Sched& S, const Epi& E) {
    const int tid = opaque_tid(), wid = __builtin_amdgcn_readfirstlane(tid >> 6), lane = tid & 63, wr = wid >> 2, wc = wid & 3, fr = lane & 15, fq = lane >> 4;
    const int K = g.K, nt = K / BK;
    unsigned voffA[2], voffB[2];
#pragma unroll
    for (int i = 0; i < 2; ++i) { int R, C; stage_rc(tid * 16 + i * 8192, R, C); const int Rb = Epi::PERM ? ((R & ~31) + perm32(R & 31)) : R;
        voffA[i] = (unsigned)(R * g.lda + C) * 2u; voffB[i] = (unsigned)(Rb * K + C) * 2u; }
    const size_t kstep = (size_t)(BK * 2);
    const size_t hstepA = (size_t)HALF * g.lda * 2, tstepA = 2 * hstepA;
    const size_t hstepB = (size_t)HALF * K * 2, tstepB = 2 * hstepB;
    const unsigned ldsw = (unsigned)wid * 1024u;
    const int aoff = lds_byte(wr * 64 + fr, fq * 8), boff = lds_byte(wc * 32 + fr, fq * 8);
#define PG8_SA(b, h) (((b) * 2 + (h)) * HTB)
#define PG8_SB(b, h) ((4 + (b) * 2 + (h)) * HTB)
#define PG8_STAGE(bufoff, gbase, voff) do { _Pragma("unroll") for (int _i = 0; _i < 2; ++_i) \
        __builtin_amdgcn_global_load_lds((const unsigned*)((const char*)(gbase) + (voff)[_i]), (LAS unsigned*)(lds + (bufoff) + ldsw + _i * 8192), 16, 0, 0); } while (0)
#define PG8_LDA(dst, b, h) do { _Pragma("unroll") for (int m = 0; m < 4; ++m) _Pragma("unroll") for (int k = 0; k < 2; ++k) dst[m][k] = *(const LAS bf16x8*)(lds + PG8_SA(b, h) + aoff + m * 2048 + k * 1024); } while (0)
#define PG8_LDB(dst, b, h) do { _Pragma("unroll") for (int n = 0; n < 2; ++n) _Pragma("unroll") for (int k = 0; k < 2; ++k) dst[n][k] = *(const LAS bf16x8*)(lds + PG8_SB(b, h) + boff + n * 2048 + k * 1024); } while (0)
#define PG8_MMA(ai, bj, At, Bt) do { __builtin_amdgcn_s_setprio(1); _Pragma("unroll") for (int m = 0; m < 4; ++m) _Pragma("unroll") for (int n = 0; n < 2; ++n) _Pragma("unroll") for (int k = 0; k < 2; ++k) \
        acc[ai][bj][m][n] = __builtin_amdgcn_mfma_f32_16x16x32_bf16(Bt[n][k], At[m][k], acc[ai][bj][m][n], 0, 0, 0); __builtin_amdgcn_s_setprio(0); } while (0)
#define PG8_WAIT_V(n) asm volatile("s_waitcnt vmcnt(" #n ")" ::: "memory")
#define PG8_WAIT_L(n) asm volatile("s_waitcnt lgkmcnt(" #n ")" ::: "memory")
#define PG8_BAR __builtin_amdgcn_s_barrier()
#define PG8_SCHED __builtin_amdgcn_sched_barrier(0)
    Unit cur, nxt; int ui = 0;
    if (!S.next(0, cur)) return;
    f32x4 acc[2][2][4][2];
#pragma unroll
    for (int a = 0; a < 2; ++a)
#pragma unroll
        for (int b = 0; b < 2; ++b)
#pragma unroll
            for (int m = 0; m < 4; ++m)
#pragma unroll
                for (int n = 0; n < 2; ++n) acc[a][b][m][n] = (f32x4){0.f, 0.f, 0.f, 0.f};
    bf16x8 At[4][2], B0[2][2], B1[2][2];
    const char* cA = (const char*)g.A + (size_t)(cur.pn / g.asel_div) * g.asel_stride * 2 + (size_t)cur.pm * tstepA; const char* cB = (const char*)g.Bt + (size_t)cur.pn * tstepB;
    PG8_STAGE(PG8_SB(0, 0), cB, voffB); PG8_STAGE(PG8_SA(0, 0), cA, voffA); PG8_STAGE(PG8_SB(0, 1), cB + hstepB, voffB); PG8_STAGE(PG8_SA(0, 1), cA + hstepA, voffA);
    if (wr == 1) PG8_BAR;
    PG8_WAIT_V(4); PG8_BAR;
    PG8_STAGE(PG8_SB(1, 0), cB + kstep, voffB); PG8_STAGE(PG8_SA(1, 0), cA + kstep, voffA); PG8_STAGE(PG8_SB(1, 1), cB + hstepB + kstep, voffB);
    PG8_WAIT_V(6); PG8_BAR;
    for (;;) {
        const bool has_next = S.next(ui + 1, nxt);
        const char* nA = has_next ? (const char*)g.A + (size_t)(nxt.pn / g.asel_div) * g.asel_stride * 2 + (size_t)nxt.pm * tstepA : cA; const char* nB = has_next ? (const char*)g.Bt + (size_t)nxt.pn * tstepB : cB;
        for (int t = 0; t < nt; t += 2) {
            const bool last = (t == nt - 2);
            const char* a1 = cA + (size_t)(t + 1) * kstep;
            const char* a2 = last ? nA : cA + (size_t)(t + 2) * kstep; const char* b2 = last ? nB : cB + (size_t)(t + 2) * kstep;
            const char* a3 = a2 + kstep; const char* b3 = b2 + kstep;
            PG8_LDB(B0, 0, 0); PG8_SCHED; PG8_LDA(At, 0, 0); PG8_STAGE(PG8_SA(1, 1), a1 + hstepA, voffA);
            PG8_WAIT_L(8); PG8_BAR; PG8_WAIT_L(0); PG8_MMA(0, 0, At, B0); PG8_BAR; PG8_SCHED;
            PG8_LDB(B1, 0, 1); PG8_STAGE(PG8_SB(0, 0), b2, voffB);
            PG8_BAR; PG8_WAIT_L(0); PG8_MMA(0, 1, At, B1); PG8_BAR;
            PG8_LDA(At, 0, 1); PG8_STAGE(PG8_SA(0, 0), a2, voffA);
            PG8_BAR; PG8_WAIT_L(0); PG8_MMA(1, 0, At, B0); PG8_BAR; PG8_SCHED;
            PG8_STAGE(PG8_SB(0, 1), b2 + hstepB, voffB);
            PG8_WAIT_V(6); PG8_BAR; PG8_MMA(1, 1, At, B1); PG8_BAR;
            PG8_LDB(B0, 1, 0); PG8_SCHED; PG8_LDA(At, 1, 0); PG8_STAGE(PG8_SA(0, 1), a2 + hstepA, voffA);
            PG8_WAIT_L(8); PG8_BAR; PG8_WAIT_L(0); PG8_MMA(0, 0, At, B0); PG8_BAR; PG8_SCHED;
            PG8_LDB(B1, 1, 1); PG8_STAGE(PG8_SB(1, 0), b3, voffB);
            PG8_BAR; PG8_WAIT_L(0); PG8_MMA(0, 1, At, B1); PG8_BAR;
            PG8_LDA(At, 1, 1); PG8_STAGE(PG8_SA(1, 0), a3, voffA);
            PG8_BAR; PG8_WAIT_L(0); PG8_MMA(1, 0, At, B0); PG8_BAR; PG8_SCHED;
            PG8_STAGE(PG8_SB(1, 1), b3 + hstepB, voffB);
            PG8_WAIT_V(6); PG8_BAR; PG8_MMA(1, 1, At, B1); PG8_BAR;
        }
        E(acc, cur, wr, wc, fr, fq);
        if (!has_next) break;
#pragma unroll
        for (int a = 0; a < 2; ++a)
#pragma unroll
            for (int b = 0; b < 2; ++b)
#pragma unroll
                for (int m = 0; m < 4; ++m)
#pragma unroll
                    for (int n = 0; n < 2; ++n) acc[a][b][m][n] = (f32x4){0.f, 0.f, 0.f, 0.f};
        cur = nxt; cA = nA; cB = nB; ++ui;
    }
    PG8_WAIT_V(0);
    if (wr == 0) PG8_BAR;
    PG8_BAR;
#undef PG8_SA
#undef PG8_SB
#undef PG8_STAGE
#undef PG8_LDA
#undef PG8_LDB
#undef PG8_MMA
#undef PG8_WAIT_V
#undef PG8_WAIT_L
#undef PG8_BAR
#undef PG8_SCHED
}
}
using pg8::Unit;

__device__ __forceinline__ float row_rstd(const float* ssq, int row) {
  const f32x4 a = *(const f32x4*)(ssq + (size_t)row * 4) + *(const f32x4*)(ssq + (size_t)(T + row) * 4) + *(const f32x4*)(ssq + (size_t)(2 * T + row) * 4) + *(const f32x4*)(ssq + (size_t)(3 * T + row) * 4);
  return rsqrtf((a[0] + a[1] + a[2] + a[3]) * (1.0f / 1024.0f) + EPS);
}

__device__ __forceinline__ void rows_rstd8(const float* ssq, int row0, int fq, float (&rs)[2][4]) {
  f32x4 pv[2][4];
#pragma unroll
  for (int ai = 0; ai < 2; ++ai)
#pragma unroll
    for (int m = 0; m < 4; ++m) pv[ai][m] = *(const f32x4*)(ssq + ((size_t)fq * T + row0 + ai * 128 + m * 16) * 4);
#pragma unroll
  for (int ai = 0; ai < 2; ++ai)
#pragma unroll
    for (int m = 0; m < 4; ++m) {
      float t = (pv[ai][m][0] + pv[ai][m][1]) + (pv[ai][m][2] + pv[ai][m][3]);
      t += __shfl_xor(t, 16); t += __shfl_xor(t, 32);
      rs[ai][m] = rsqrtf(t * (1.0f / 1024.0f) + EPS);
    }
}
struct EpiProj {
  static constexpr bool PERM = true;
  bf16_t* proj; float* gs; const float* ssq; int smask;
  __device__ __forceinline__ void operator()(const f32x4 (&acc)[2][2][4][2], const Unit& u, int wr, int wc, int fr, int fq) const {
    const int row0 = u.pm * 256 + wr * 64 + fr, col0 = u.pn * 256 + wc * 32 + 8 * fq;
    const bool rot = (u.pn >= 12) && (u.pn < 16);
    float inv[8];
    if (rot) {
#pragma unroll
      for (int e = 0; e < 8; ++e) inv[e] = __builtin_amdgcn_exp2f(-(float)((wc * 32 + 8 * fq + e) & 63) * (13.287712379549449f / 64.0f)) * 0.15915494309189535f;
    }
    const float ksc = (u.pn >= 14) ? 0.08838834764831845f : 1.0f;
    float rsa[2][4];
    rows_rstd8(ssq, row0, fq, rsa);
#pragma unroll
    for (int ai = 0; ai < 2; ++ai) {
      float rs[4];
#pragma unroll
      for (int m = 0; m < 4; ++m) rs[m] = rsa[ai][m];
#pragma unroll
      for (int m = 0; m < 4; ++m) {
        const int row = row0 + ai * 128 + m * 16;
        if (rot) {
          const float pos = (float)(row & smask), sc = rs[m] * ksc;
          float o1[8], o2[8];
#pragma unroll
          for (int e = 0; e < 8; ++e) {
            float r = pos * inv[e]; r = r - floorf(r);
            const float sn = __builtin_amdgcn_sinf(r), cs = __builtin_amdgcn_cosf(r);
            const float t1 = acc[ai][0][m][e >> 2][e & 3] * sc, t2 = acc[ai][1][m][e >> 2][e & 3] * sc;
            o1[e] = t1 * cs - t2 * sn; o2[e] = t1 * sn + t2 * cs;
          }
          u32x4 w1, w2;
          w1.x = cvt_pk_bf16(o1[0], o1[1]); w1.y = cvt_pk_bf16(o1[2], o1[3]); w1.z = cvt_pk_bf16(o1[4], o1[5]); w1.w = cvt_pk_bf16(o1[6], o1[7]);
          w2.x = cvt_pk_bf16(o2[0], o2[1]); w2.y = cvt_pk_bf16(o2[2], o2[3]); w2.z = cvt_pk_bf16(o2[4], o2[5]); w2.w = cvt_pk_bf16(o2[6], o2[7]);
          *(u32x4*)(proj + (size_t)row * PLD + col0) = w1; *(u32x4*)(proj + (size_t)row * PLD + col0 + 128) = w2;
        } else {
#pragma unroll
          for (int bj = 0; bj < 2; ++bj) {
            const int c = col0 + bj * 128;
            f32x4 v0 = acc[ai][bj][m][0] * rs[m], v1 = acc[ai][bj][m][1] * rs[m];
            if (c < NPROJ) { u32x4 w; w.x = cvt_pk_bf16(v0[0], v0[1]); w.y = cvt_pk_bf16(v0[2], v0[3]); w.z = cvt_pk_bf16(v1[0], v1[1]); w.w = cvt_pk_bf16(v1[2], v1[3]);
              *(u32x4*)(proj + (size_t)row * PLD + c) = w; }
            if (c >= C_DT && c < C_DT + 32) { float* q = gs + (size_t)row * 32 + (c - C_DT); *(f32x4*)q = v0; *(f32x4*)(q + 4) = v1; }
            if (c >= C_MLG && c < C_MLG + 16) { float* q = gs + (size_t)T * 32 + (size_t)row * 16 + (c - C_MLG); *(f32x4*)q = v0; *(f32x4*)(q + 4) = v1; }
          }
        }
      }
    }
  }
};
struct EpiGate {
  static constexpr bool PERM = true;
  bf16_t* gate; const float* bias; const float* ssq;
  __device__ __forceinline__ void operator()(const f32x4 (&acc)[2][2][4][2], const Unit& u, int wr, int wc, int fr, int fq) const {
    const int row0 = u.pm * 256 + wr * 64 + fr, col0 = u.pn * 256 + wc * 32 + 8 * fq;
    float rs[2][4]; f32x4 bv[2][2];
#pragma unroll
    for (int bj = 0; bj < 2; ++bj) { bv[bj][0] = *(const f32x4*)(bias + col0 + bj * 128); bv[bj][1] = *(const f32x4*)(bias + col0 + bj * 128 + 4); }
    rows_rstd8(ssq, row0, fq, rs);
#pragma unroll
    for (int ai = 0; ai < 2; ++ai)
#pragma unroll
      for (int m = 0; m < 4; ++m) {
        const int row = row0 + ai * 128 + m * 16;
#pragma unroll
        for (int bj = 0; bj < 2; ++bj) {
          const int c = col0 + bj * 128;
          f32x4 v0 = acc[ai][bj][m][0] * rs[ai][m] + bv[bj][0], v1 = acc[ai][bj][m][1] * rs[ai][m] + bv[bj][1];
#pragma unroll
          for (int j = 0; j < 4; ++j) { v0[j] = sigmoidf_(v0[j]); v1[j] = sigmoidf_(v1[j]); }
          u32x4 w; w.x = cvt_pk_bf16(v0[0], v0[1]); w.y = cvt_pk_bf16(v0[2], v0[3]); w.z = cvt_pk_bf16(v1[0], v1[1]); w.w = cvt_pk_bf16(v1[2], v1[3]);
          *(u32x4*)(gate + (size_t)row * 3072 + c) = w;
        }
      }
  }
};
struct EpiBranch {
  static constexpr bool PERM = true;
  const bf16_t* gate; bf16_t* merged;
  __device__ __forceinline__ void operator()(const f32x4 (&acc)[2][2][4][2], const Unit& u, int wr, int wc, int fr, int fq) const {
    const int br = u.pn >> 2;
    const int row0 = u.pm * 256 + wr * 64 + fr, col0 = u.pn * 256 + wc * 32 + 8 * fq, mcol0 = (u.pn & 3) * 256 + wc * 32 + 8 * fq;
#pragma unroll
    for (int ai = 0; ai < 2; ++ai) {
      u32x4 gw[4][2], mw[4][2];
#pragma unroll
      for (int m = 0; m < 4; ++m)
#pragma unroll
        for (int bj = 0; bj < 2; ++bj) {
          gw[m][bj] = *(const u32x4*)(gate + (size_t)(row0 + ai * 128 + m * 16) * 3072 + col0 + bj * 128);
          mw[m][bj] = br ? *(const u32x4*)(merged + (size_t)(row0 + ai * 128 + m * 16) * 1024 + mcol0 + bj * 128) : (u32x4){0u, 0u, 0u, 0u};
        }
#pragma unroll
      for (int m = 0; m < 4; ++m) {
        const int row = row0 + ai * 128 + m * 16;
#pragma unroll
        for (int bj = 0; bj < 2; ++bj) {
          const u32x4 g = gw[m][bj], o = mw[m][bj];
          const f32x4 a0 = acc[ai][bj][m][0], a1 = acc[ai][bj][m][1];
          u32x4 w;
          w.x = cvt_pk_bf16(a0[0] * bflo(g.x) + bflo(o.x), a0[1] * bfhi(g.x) + bfhi(o.x)); w.y = cvt_pk_bf16(a0[2] * bflo(g.y) + bflo(o.y), a0[3] * bfhi(g.y) + bfhi(o.y));
          w.z = cvt_pk_bf16(a1[0] * bflo(g.z) + bflo(o.z), a1[1] * bfhi(g.z) + bfhi(o.z)); w.w = cvt_pk_bf16(a1[2] * bflo(g.w) + bflo(o.w), a1[3] * bfhi(g.w) + bfhi(o.w));
          *(u32x4*)(merged + (size_t)row * 1024 + mcol0 + bj * 128) = w;
        }
      }
    }
  }
};
struct EpiRes {
  static constexpr bool PERM = true;
  bf16_t* xb; float* ssq;
  __device__ __forceinline__ void operator()(const f32x4 (&acc)[2][2][4][2], const Unit& u, int wr, int wc, int fr, int fq) const {
    const int row0 = u.pm * 256 + wr * 64 + fr, col0 = u.pn * 256 + wc * 32 + 8 * fq;
#pragma unroll
    for (int ai = 0; ai < 2; ++ai) {
      u32x4 xw[2][4][2];
#pragma unroll
      for (int m = 0; m < 4; ++m)
#pragma unroll
        for (int bj = 0; bj < 2; ++bj) xw[ai][m][bj] = *(const u32x4*)(xb + (size_t)(row0 + ai * 128 + m * 16) * 1024 + col0 + bj * 128);
#pragma unroll
      for (int m = 0; m < 4; ++m) {
        const int row = row0 + ai * 128 + m * 16; float sq = 0.f;
#pragma unroll
        for (int bj = 0; bj < 2; ++bj) {
          const u32x4 o = xw[ai][m][bj];
          f32x4 v0 = acc[ai][bj][m][0], v1 = acc[ai][bj][m][1];
          v0[0] += bflo(o.x); v0[1] += bfhi(o.x); v0[2] += bflo(o.y); v0[3] += bfhi(o.y);
          v1[0] += bflo(o.z); v1[1] += bfhi(o.z); v1[2] += bflo(o.w); v1[3] += bfhi(o.w);
          u32x4 w; w.x = cvt_pk_bf16(v0[0], v0[1]); w.y = cvt_pk_bf16(v0[2], v0[3]); w.z = cvt_pk_bf16(v1[0], v1[1]); w.w = cvt_pk_bf16(v1[2], v1[3]);
          *(u32x4*)(xb + (size_t)row * 1024 + col0 + bj * 128) = w;
          sq += ((v0[0] * v0[0] + v0[1] * v0[1]) + (v0[2] * v0[2] + v0[3] * v0[3])) + ((v1[0] * v1[0] + v1[1] * v1[1]) + (v1[2] * v1[2] + v1[3] * v1[3]));
        }
        sq += __shfl_xor(sq, 16); sq += __shfl_xor(sq, 32);
        if (fq == 0) ssq[((size_t)u.pn * T + row) * 4 + wc] = sq;
      }
    }
  }
};
struct EpiFfn {
  static constexpr bool PERM = true;
  bf16_t* hid; const float* ssq;
  __device__ __forceinline__ void operator()(const f32x4 (&acc)[2][2][4][2], const Unit& u, int wr, int wc, int fr, int fq) const {
    const int row0 = u.pm * 256 + wr * 64 + fr, hc = u.pn * 128 + wc * 32 + 8 * fq;
    float rs[2][4];
    rows_rstd8(ssq, row0, fq, rs);
#pragma unroll
    for (int ai = 0; ai < 2; ++ai)
#pragma unroll
      for (int m = 0; m < 4; ++m) {
        const int row = row0 + ai * 128 + m * 16; const float r = rs[ai][m];
        f32x4 o0, o1;
#pragma unroll
        for (int j = 0; j < 4; ++j) {
          o0[j] = siluf_(acc[ai][0][m][0][j] * r) * (acc[ai][1][m][0][j] * r);
          o1[j] = siluf_(acc[ai][0][m][1][j] * r) * (acc[ai][1][m][1][j] * r);
        }
        u32x4 w; w.x = cvt_pk_bf16(o0[0], o0[1]); w.y = cvt_pk_bf16(o0[2], o0[3]); w.z = cvt_pk_bf16(o1[0], o1[1]); w.w = cvt_pk_bf16(o1[2], o1[3]);
        *(u32x4*)(hid + (size_t)row * FF + hc) = w;
      }
  }
};

__device__ __forceinline__ int map_w1(int r) {
  if (r < 2560) return r;
  if (r < 3072) return r + 32;
  if (r < 4096) { const int isk = r >= 3584, q = r - (isk ? 3584 : 3072), t = q >> 8, w = q & 255, head = 2 * t + ((w >> 6) & 1), half = w >> 7, i = w & 63;
                  return (isk ? 6192 : 5680) + head * 128 + half * 64 + i; }
  if (r < 4608) return r - 4096 + 3104;
  if (r < 5632) return r - 4608 + 3616;
  if (r < 6656) return r - 5632 + 4640;
  if (r < 7680) return r - 6656 + 6704;
  if (r < 8704) return r - 7680 + 7728;
  if (r < 8736) return r - 8704 + 2560;
  if (r < 8752) return r - 8736 + 5664;
  return -1;
}
__device__ __forceinline__ void cvt_tile(LAS float* tl, const float* src, int sld, int k0, int n0, int nvalid, const float* scale,
                                         bf16_t* dst, int dld, int r0, int c0, int ncopy, bool w1map) {
  const int tid = opaque_tid();
#pragma unroll
  for (int it = 0; it < 2; ++it) {
    const int k = (tid >> 4) + it * 32, n4 = (tid & 15) * 4;
    f32x4 v = (f32x4){0.f, 0.f, 0.f, 0.f};
    const int sc_ = w1map ? map_w1(n0 + n4) : (n0 + n4 < nvalid ? n0 + n4 : -1);
    if (sc_ >= 0) v = *(const f32x4*)(src + (size_t)(k0 + k) * sld + sc_);
    const float s = scale ? scale[k0 + k] : 1.f;
    tl[k * 65 + n4 + 0] = v[0] * s; tl[k * 65 + n4 + 1] = v[1] * s; tl[k * 65 + n4 + 2] = v[2] * s; tl[k * 65 + n4 + 3] = v[3] * s;
  }
  __syncthreads();
  const int n = tid >> 3, k8 = (tid & 7) * 8;
  u32x4 w;
  w.x = cvt_pk_bf16(tl[(k8 + 0) * 65 + n], tl[(k8 + 1) * 65 + n]); w.y = cvt_pk_bf16(tl[(k8 + 2) * 65 + n], tl[(k8 + 3) * 65 + n]);
  w.z = cvt_pk_bf16(tl[(k8 + 4) * 65 + n], tl[(k8 + 5) * 65 + n]); w.w = cvt_pk_bf16(tl[(k8 + 6) * 65 + n], tl[(k8 + 7) * 65 + n]);
  for (int cp = 0; cp < ncopy; ++cp) *(u32x4*)(dst + (size_t)(r0 + n) * dld + c0 + cp * 1024 + k8) = w;
  __syncthreads();
}

__device__ void phase_convert(const Params& p, int layer, LAS unsigned char* lds, int parity, int first, int stride) {
  LAS float* tl = (LAS float*)lds;
  const float* gmix = p.in[2] + layer * 1024;
  const float* w_in = p.in[3] + (size_t)layer * 1024 * NPROJ;
  const float* w_gate = p.in[4] + (size_t)layer * 1024 * 3072;
  const float* w_branch = p.in[15] + (size_t)layer * 3 * 1024 * 1024;
  const float* w_out = p.in[16] + (size_t)layer * 1024 * 1024;
  const float* gffn = p.in[17] + layer * 1024;
  const float* w_fg = p.in[18] + (size_t)layer * 1024 * FF;
  const float* w_fu = p.in[19] + (size_t)layer * 1024 * FF;
  const float* w_fd = p.in[20] + (size_t)layer * FF * 1024;
  unsigned char* wb = p.ws + (parity ? WS_WB : 0);
  bf16_t* W1 = (bf16_t*)(wb + WS_W1); bf16_t* WG = (bf16_t*)(wb + WS_WG); bf16_t* W2 = (bf16_t*)(wb + WS_W2);
  bf16_t* W3 = (bf16_t*)(wb + WS_W3); bf16_t* W4 = (bf16_t*)(wb + WS_W4); bf16_t* W5 = (bf16_t*)(wb + WS_W5);
  for (int t = first; t < 6144; t += stride) {
    int i = t;
    const float* src; const float* scale = nullptr; bf16_t* dst; int sld, k0, n0, nvalid, dld, r0, ncopy = 1;
    if (i < 2240) { const int nt = i >> 4; k0 = (i & 15) * 64; n0 = nt * 64; src = w_in; sld = NPROJ; nvalid = NPROJ; scale = gmix; dst = W1; dld = 1024; r0 = n0; }
    else if ((i -= 2240) < 768) { const int nt = i >> 4; k0 = (i & 15) * 64; n0 = nt * 64; src = w_gate; sld = 3072; nvalid = 3072; scale = gmix; dst = WG; dld = 1024; r0 = n0; }
    else if ((i -= 768) < 768) { const int br = i >> 8, j = i & 255, nt = j >> 4; k0 = (j & 15) * 64; n0 = nt * 64; src = w_branch + (size_t)br * 1024 * 1024; sld = 1024; nvalid = 1024; dst = W2; dld = 1024; r0 = br * 1024 + n0; }
    else if ((i -= 768) < 256) { const int nt = i >> 4; k0 = (i & 15) * 64; n0 = nt * 64; src = w_out; sld = 1024; nvalid = 1024; dst = W3; dld = 1024; r0 = n0; }
    else if ((i -= 256) < 1408) { const int nt = i >> 4, pp = nt >> 2, half = (nt >> 1) & 1, sub = nt & 1; k0 = (i & 15) * 64; n0 = pp * 128 + sub * 64; src = half ? w_fu : w_fg; sld = FF; nvalid = FF; scale = gffn; dst = W4; dld = 1024; r0 = pp * 256 + half * 128 + sub * 64; }
    else { i -= 1408; const int nt = i / 44; k0 = (i % 44) * 64; n0 = nt * 64; src = w_fd; sld = 1024; nvalid = 1024; dst = W5; dld = FF; r0 = n0; }
    cvt_tile(tl, src, sld, k0, n0, nvalid, scale, dst, dld, r0, k0, ncopy, t < 2240);
  }
}

__device__ void phase_load_rows(const float* xin, bf16_t* xb, float* ssq) {
  const int tid_ = opaque_tid(); const int lane = tid_ & 63, wid = tid_ >> 6;
  for (int row = blockIdx.x * 8 + wid; row < T; row += gridDim.x * 8) {
    float sq = 0.f;
#pragma unroll
    for (int i = 0; i < 4; ++i) {
      const size_t off = (size_t)row * 1024 + i * 256 + lane * 4;
      const f32x4 v = *(const f32x4*)(xin + off);
      u32x2 w; w.x = cvt_pk_bf16(v[0], v[1]); w.y = cvt_pk_bf16(v[2], v[3]); *(u32x2*)(xb + off) = w;
      sq += (v[0] * v[0] + v[1] * v[1]) + (v[2] * v[2] + v[3] * v[3]);
    }
#pragma unroll
    for (int o = 1; o < 64; o <<= 1) sq += __shfl_xor(sq, o);
    if (lane < 16) ssq[((size_t)(lane >> 2) * T + row) * 4 + (lane & 3)] = lane == 0 ? sq : 0.f;
  }
}
__device__ void phase_final_norm(const bf16_t* xb, float* out, const float* ssq, const float* g) {
  const int tid_ = opaque_tid(); const int lane = tid_ & 63, wid = tid_ >> 6;
  for (int row = blockIdx.x * 8 + wid; row < T; row += gridDim.x * 8) {
    const float rs = row_rstd(ssq, row);
#pragma unroll
    for (int i = 0; i < 4; ++i) {
      const size_t off = (size_t)row * 1024 + i * 256 + lane * 4;
      const u32x2 w = *(const u32x2*)(xb + off); const f32x4 gg = *(const f32x4*)(g + i * 256 + lane * 4);
      const f32x4 v = (f32x4){bflo(w.x), bfhi(w.x), bflo(w.y), bfhi(w.y)};
      *(f32x4*)(out + off) = v * rs * gg;
    }
  }
}

__device__ void phase_conv(const bf16_t* __restrict__ proj, bf16_t* __restrict__ xc, const float* cw, const float* cb, int S) {
  const int tid_ = opaque_tid();
  const int nitems = 192 * (T / 32);
  for (int id = blockIdx.x * 512 + tid_; id < nitems; id += gridDim.x * 512) {
    const int cg = id % 192, c8 = cg * 8, t0 = (id / 192) * 32, pos0 = t0 % S;
    float wt[4][8], bs[8];
#pragma unroll
    for (int e = 0; e < 8; ++e) bs[e] = cb[c8 + e];
#pragma unroll
    for (int tau = 0; tau < 4; ++tau)
#pragma unroll
      for (int e = 0; e < 8; ++e) wt[tau][e] = cw[tau * 1536 + c8 + e];
    const bf16_t* src = proj + C_XBC + c8;
    const u32x4 zero = (u32x4){0u, 0u, 0u, 0u};
    u32x4 w0 = (pos0 >= 2) ? *(const u32x4*)(src + (size_t)(t0 - 2) * PLD) : zero;
    u32x4 w1 = (pos0 >= 1) ? *(const u32x4*)(src + (size_t)(t0 - 1) * PLD) : zero;
    u32x4 w2 = *(const u32x4*)(src + (size_t)t0 * PLD);
#pragma unroll 1
    for (int b = 0; b < 4; ++b) {
      u32x4 nx[8];
#pragma unroll
      for (int k = 0; k < 8; ++k) { const int tt = t0 + b * 8 + k + 1; nx[k] = (pos0 + b * 8 + k + 1 < S) ? *(const u32x4*)(src + (size_t)tt * PLD) : zero; }
#pragma unroll
      for (int k = 0; k < 8; ++k) {
        const u32x4 w3 = nx[k];
        float a[8];
        const unsigned r0[4] = {w0.x, w0.y, w0.z, w0.w}, r1[4] = {w1.x, w1.y, w1.z, w1.w}, r2[4] = {w2.x, w2.y, w2.z, w2.w}, r3[4] = {w3.x, w3.y, w3.z, w3.w};
#pragma unroll
        for (int q = 0; q < 4; ++q) {
          a[2 * q] = bs[2 * q] + bflo(r0[q]) * wt[0][2 * q] + bflo(r1[q]) * wt[1][2 * q] + bflo(r2[q]) * wt[2][2 * q] + bflo(r3[q]) * wt[3][2 * q];
          a[2 * q + 1] = bs[2 * q + 1] + bfhi(r0[q]) * wt[0][2 * q + 1] + bfhi(r1[q]) * wt[1][2 * q + 1] + bfhi(r2[q]) * wt[2][2 * q + 1] + bfhi(r3[q]) * wt[3][2 * q + 1];
        }
#pragma unroll
        for (int e = 0; e < 8; ++e) a[e] = siluf_(a[e]);
        u32x4 o; o.x = cvt_pk_bf16(a[0], a[1]); o.y = cvt_pk_bf16(a[2], a[3]); o.z = cvt_pk_bf16(a[4], a[5]); o.w = cvt_pk_bf16(a[6], a[7]);
        *(u32x4*)(xc + (size_t)(t0 + b * 8 + k) * 1536 + c8) = o;
        w0 = w1; w1 = w2; w2 = w3;
      }
    }
  }
}

__device__ void phase_rope(bf16_t* proj, int S) {
  const int tid_ = opaque_tid();
  const size_t total = (size_t)T * 32;
  for (size_t id = (size_t)blockIdx.x * 512 + tid_; id < total; id += (size_t)gridDim.x * 512) {
    const int t = (int)(id >> 5), hd = (int)(id >> 3) & 3, ch = (int)id & 7;
    bf16_t* src = proj + (size_t)t * PLD + hd * 128 + ch * 8;
    const u32x4 q1 = *(const u32x4*)(src + C_RTQ), q2 = *(const u32x4*)(src + C_RTQ + 64), k1 = *(const u32x4*)(src + C_RTK), k2 = *(const u32x4*)(src + C_RTK + 64);
    const float pos = (float)(t % S);
    float cs[8], sn[8];
#pragma unroll
    for (int e = 0; e < 8; ++e) {
      const float inv = __builtin_amdgcn_exp2f(-(float)(ch * 8 + e) * (13.287712379549449f / 64.0f));
      float r = pos * inv * 0.15915494309189535f; r = r - floorf(r);
      sn[e] = __builtin_amdgcn_sinf(r); cs[e] = __builtin_amdgcn_cosf(r);
    }
    const float ksc = 0.08838834764831845f;
    const unsigned qa[4] = {q1.x, q1.y, q1.z, q1.w}, qb[4] = {q2.x, q2.y, q2.z, q2.w}, ka[4] = {k1.x, k1.y, k1.z, k1.w}, kb[4] = {k2.x, k2.y, k2.z, k2.w};
    unsigned oq1[4], oq2[4], ok1[4], ok2[4];
#pragma unroll
    for (int w = 0; w < 4; ++w) {
      const float a0 = bflo(qa[w]), a1 = bfhi(qa[w]), b0 = bflo(qb[w]), b1 = bfhi(qb[w]);
      oq1[w] = cvt_pk_bf16(a0 * cs[2 * w] - b0 * sn[2 * w], a1 * cs[2 * w + 1] - b1 * sn[2 * w + 1]);
      oq2[w] = cvt_pk_bf16(a0 * sn[2 * w] + b0 * cs[2 * w], a1 * sn[2 * w + 1] + b1 * cs[2 * w + 1]);
      const float e0 = bflo(ka[w]) * ksc, e1 = bfhi(ka[w]) * ksc, g0 = bflo(kb[w]) * ksc, g1 = bfhi(kb[w]) * ksc;
      ok1[w] = cvt_pk_bf16(e0 * cs[2 * w] - g0 * sn[2 * w], e1 * cs[2 * w + 1] - g1 * sn[2 * w + 1]);
      ok2[w] = cvt_pk_bf16(e0 * sn[2 * w] + g0 * cs[2 * w], e1 * sn[2 * w + 1] + g1 * cs[2 * w + 1]);
    }
    *(u32x4*)(src + C_RTQ) = (u32x4){oq1[0], oq1[1], oq1[2], oq1[3]};
    *(u32x4*)(src + C_RTQ + 64) = (u32x4){oq2[0], oq2[1], oq2[2], oq2[3]};
    *(u32x4*)(src + C_RTK) = (u32x4){ok1[0], ok1[1], ok1[2], ok1[3]};
    *(u32x4*)(src + C_RTK + 64) = (u32x4){ok2[0], ok2[1], ok2[2], ok2[3]};
  }
}

constexpr int MXP = 272;
constexpr int MX_Q = 0, MX_K = 34816, MX_KT = 69632, MX_VT = 104448, MX_HT = 121856, MX_V = 139264, MX_N = 155648, MX_VEC = 155904, MX_END = MX_VEC + 7 * 512 + 64;
constexpr int LDS_XB = MX_END > pg8::STAGE_BYTES ? MX_END : pg8::STAGE_BYTES;
constexpr int LDS_BYTES = LDS_XB + 16;

__device__ __forceinline__ int swz(int row, int col) { return row * MXP + col * 2; }
__device__ __forceinline__ bf16x8 ldfrag(LAS const unsigned char* base, int row0, int ks, int lane) {
  const int row = row0 + (lane & 31);
  return *(LAS const bf16x8*)(base + row * MXP + (lane >> 5) * 16 + ks * 32);
}
__device__ __forceinline__ u32x4 scale_pk(u32x4 v, float s) {
  u32x4 w; w.x = cvt_pk_bf16(bflo(v.x) * s, bfhi(v.x) * s); w.y = cvt_pk_bf16(bflo(v.y) * s, bfhi(v.y) * s);
  w.z = cvt_pk_bf16(bflo(v.z) * s, bfhi(v.z) * s); w.w = cvt_pk_bf16(bflo(v.w) * s, bfhi(v.w) * s); return w;
}

template <int BR, bool DEN>
__device__ void mixer_item(const Params& p, LAS unsigned char* lds, int layer, int S, int seq, int dir, int ht) {
  const int tid = opaque_tid(), wid = __builtin_amdgcn_readfirstlane(tid >> 6), lane = tid & 63, rb = wid >> 1, cb = wid & 1;
  const bf16_t* proj = (const bf16_t*)(p.ws + WS_PROJ);
  const bf16_t* xc = (const bf16_t*)(p.ws + WS_XC);
  const float* gs = (const float*)(p.ws + WS_GS);
  bf16_t* yout = (bf16_t*)(p.ws + (dir ? WS_YB : WS_YF));
  LAS float* vC = (LAS float*)(lds + MX_VEC); LAS float* vMu = vC + 128; LAS float* vW = vC + 256; LAS float* vR = vC + 384; LAS float* vCl = vC + 512; LAS float* vVs = vC + 640; LAS float* sc = vC + 896;
  constexpr bool STAB = (BR == 1);
  int hd, vt, ocol;
  if (BR == 0) { hd = ht; vt = 0; ocol = ht * 64; } else if (DEN) { hd = ht; vt = 0; ocol = 0; } else { hd = ht >> 2; vt = ht & 3; ocol = (BR == 1 ? 1024 : 2048) + hd * 256 + vt * 64; }
  float cst_a = 0.f, cst_b = 0.f, cst_c = 0.f;
  if (BR == 0) { cst_a = -expf(p.in[8][layer * 32 + dir * 16 + hd]); cst_b = p.in[9][layer * 32 + dir * 16 + hd]; }
  if (BR == 1) { cst_b = p.in[12][layer * 16 + (2 * dir) * 4 + hd]; cst_c = p.in[12][layer * 16 + (2 * dir + 1) * 4 + hd]; }
  if (BR == 2) { cst_a = logf(1.0f - exp2f(-5.0f - (4.0f / 3.0f) * (float)hd)); }
  const int nc = S / 128;
  const int seqbase = seq * S;
  f32x16 Hacc;
#pragma unroll
  for (int j = 0; j < 16; ++j) Hacc[j] = 0.f;
  float m_st = 0.f;
  { unsigned z0 = 0u; asm volatile("" : "+v"(z0)); const u32x4 zv = (u32x4){z0, z0, z0, z0};
    for (int i = tid; i < 64 * MXP / 16; i += 512) *(LAS u32x4*)(lds + MX_HT + i * 16) = zv;
    if (tid < 16) *(LAS u32x4*)(lds + MX_N + tid * 16) = zv; }

  u32x4 ra[8], rv[2]; float rg[4] = {0.f, 0.f, 0.f, 0.f};
#define MX_ISSUE_LOADS(ci_) do { \
    const int tk_ = seqbase + (ci_) * 128; \
    { \
      _Pragma("unroll") for (int it = 0; it < 4; ++it) { const int id = it * 512 + tid, row = id >> 4, ch = id & 15; \
        if (BR == 1) { const bf16_t* src = proj + (size_t)(tk_ + row) * PLD + hd * 128 + ch * 8; ra[it] = *(const u32x4*)(src + C_MLQ); ra[4 + it] = *(const u32x4*)(src + C_MLK); } \
        else if (BR == 2) { const bf16_t* src = proj + (size_t)(tk_ + row) * PLD + (hd >> 1) * 256 + (ch >> 3) * 128 + (hd & 1) * 64 + (ch & 7) * 8; ra[it] = *(const u32x4*)(src + C_RTQ); ra[4 + it] = *(const u32x4*)(src + C_RTK); } \
        else { const bf16_t* src = xc + (size_t)(tk_ + row) * 1536 + (hd >> 3) * 128 + ch * 8; ra[it] = *(const u32x4*)(src + 1280); ra[4 + it] = *(const u32x4*)(src + 1024); } } \
    } \
    _Pragma("unroll") for (int it = 0; it < 2; ++it) { const int id = it * 512 + tid, row = id >> 3, ch = id & 7; \
      if (DEN) rv[it] = (u32x4){0x3F803F80u, 0x3F803F80u, 0x3F803F80u, 0x3F803F80u}; \
      else if (BR == 0) rv[it] = *(const u32x4*)(xc + (size_t)(tk_ + row) * 1536 + hd * 64 + ch * 8); \
      else rv[it] = *(const u32x4*)(proj + (size_t)(tk_ + row) * PLD + (BR == 1 ? C_MLV : C_RTV) + hd * 256 + vt * 64 + ch * 8); } \
    if (wid == 0 && BR != 2) { const int q0_ = dir ? 127 - 2 * lane : 2 * lane, q1_ = dir ? 126 - 2 * lane : 2 * lane + 1; \
      if (BR == 0) { rg[0] = gs[(size_t)(tk_ + q0_) * 32 + dir * 16 + hd]; rg[1] = gs[(size_t)(tk_ + q1_) * 32 + dir * 16 + hd]; } \
      else { const float* gg = gs + (size_t)T * 32; rg[0] = gg[(size_t)(tk_ + q0_) * 16 + (2 * dir + 1) * 4 + hd]; rg[1] = gg[(size_t)(tk_ + q1_) * 16 + (2 * dir + 1) * 4 + hd]; \
        rg[2] = gg[(size_t)(tk_ + q0_) * 16 + (2 * dir) * 4 + hd]; rg[3] = gg[(size_t)(tk_ + q1_) * 16 + (2 * dir) * 4 + hd]; } } \
  } while (0)
  MX_ISSUE_LOADS(dir ? nc - 1 : 0);

  for (int c = 0; c < nc; ++c) {
    const int ci = dir ? nc - 1 - c : c;
    const int tok0 = seqbase + ci * 128;
    if (wid == 0) {
      const int j0 = 2 * lane, j1 = j0 + 1;
      const int p0 = dir ? 127 - j0 : j0, p1 = dir ? 127 - j1 : j1;
      float l0, l1, b0 = 0.f, b1 = 0.f, d0 = 1.f, d1 = 1.f;
      if (BR == 0) {
        d0 = softplusf_(rg[0] + cst_b); d1 = softplusf_(rg[1] + cst_b);
        l0 = d0 * cst_a; l1 = d1 * cst_a;
      } else if (BR == 1) {
        l0 = -softplusf_(-(rg[0] + cst_c)); l1 = -softplusf_(-(rg[1] + cst_c));
        b0 = rg[2] + cst_b; b1 = rg[3] + cst_b;
      } else { l0 = cst_a; l1 = cst_a; }
      float run = l0 + l1;
#pragma unroll
      for (int o = 1; o < 64; o <<= 1) { const float t = __shfl_up(run, o); if (lane >= o) run += t; }
      const float A1 = run, A0 = run - l1;
      const float A_end = __shfl(A1, 63);
      const float c0 = b0 - A0, c1 = b1 - A1;
      float mu0, mu1, mu_end;
      if (STAB) {
        float rm = fmaxf(c0, c1);
#pragma unroll
        for (int o = 1; o < 64; o <<= 1) { const float t = __shfl_up(rm, o); if (lane >= o) rm = fmaxf(rm, t); }
        const float ex = __shfl_up(rm, 1);
        const float pm0 = lane > 0 ? fmaxf(ex, c0) : c0, pm1 = rm;
        mu0 = fmaxf(m_st, pm0); mu1 = fmaxf(m_st, pm1); mu_end = fmaxf(m_st, __shfl(pm1, 63));
      } else { mu0 = -A0; mu1 = -A1; mu_end = -A_end; }
      vC[p0] = c0; vC[p1] = c1; vMu[p0] = mu0; vMu[p1] = mu1;
      vW[p0] = __expf(c0 - mu_end); vW[p1] = __expf(c1 - mu_end);
      vR[p0] = __expf(m_st - mu0); vR[p1] = __expf(m_st - mu1);
      vCl[p0] = STAB ? __expf(-A0 - mu0) : 0.f; vCl[p1] = STAB ? __expf(-A1 - mu1) : 0.f;
      vVs[p0] = d0; vVs[p1] = d1;
      if (lane == 0) sc[0] = __expf(m_st - mu_end);
      m_st = STAB ? A_end + mu_end : 0.f;
    }
    {
#pragma unroll
      for (int it = 0; it < 4; ++it) {
        const int id = it * 512 + tid, row = id >> 4, ch = id & 15;
        *(LAS u32x4*)(lds + MX_Q + swz(row, ch * 8)) = BR == 1 ? scale_pk(ra[it], 0.08838834764831845f) : ra[it];
        *(LAS u32x4*)(lds + MX_K + swz(row, ch * 8)) = ra[4 + it];
      }
    }
#pragma unroll
    for (int it = 0; it < 2; ++it) {
      const int id = it * 512 + tid, row = id >> 3, ch = id & 7;
      *(LAS u32x4*)(lds + MX_V + row * 128 + ch * 16) = rv[it];
    }
    __syncthreads();
    {
      const int dk = tid & 127, sg = tid >> 7, dv = tid & 63, sv = tid >> 6;
      unsigned short kr[32], vr[16];
      f32x4 w4[8], vs4[4];
#pragma unroll
      for (int i = 0; i < 32; ++i) kr[i] = *(LAS const bf16_t*)(lds + MX_K + swz(sg * 32 + i, dk));
#pragma unroll
      for (int i = 0; i < 16; ++i) vr[i] = *(LAS const bf16_t*)(lds + MX_V + (sv * 16 + i) * 128 + dv * 2);
#pragma unroll
      for (int i = 0; i < 8; ++i) w4[i] = *(LAS const f32x4*)(vW + sg * 32 + i * 4);
      if (BR == 0) {
#pragma unroll
        for (int i = 0; i < 4; ++i) vs4[i] = *(LAS const f32x4*)(vVs + sv * 16 + i * 4);
      }
      __builtin_amdgcn_sched_barrier(0);
#pragma unroll
      for (int s8 = 0; s8 < 4; ++s8) {
        float f[8];
#pragma unroll
        for (int e = 0; e < 8; ++e) f[e] = bf2f(kr[s8 * 8 + e]) * w4[s8 * 2 + (e >> 2)][e & 3];
        u32x4 w; w.x = cvt_pk_bf16(f[0], f[1]); w.y = cvt_pk_bf16(f[2], f[3]); w.z = cvt_pk_bf16(f[4], f[5]); w.w = cvt_pk_bf16(f[6], f[7]);
        *(LAS u32x4*)(lds + MX_KT + swz(dk, sg * 32 + s8 * 8)) = w;
      }
#pragma unroll
      for (int s8 = 0; s8 < 2; ++s8) {
        float f[8];
#pragma unroll
        for (int e = 0; e < 8; ++e) { f[e] = bf2f(vr[s8 * 8 + e]); if (BR == 0) f[e] *= vs4[s8 * 2 + (e >> 2)][e & 3]; }
        u32x4 w; w.x = cvt_pk_bf16(f[0], f[1]); w.y = cvt_pk_bf16(f[2], f[3]); w.z = cvt_pk_bf16(f[4], f[5]); w.w = cvt_pk_bf16(f[6], f[7]);
        *(LAS u32x4*)(lds + MX_VT + swz(dv, sv * 16 + s8 * 8)) = w;
      }
    }
    __syncthreads();
    f32x16 S0, S1, QH;
#pragma unroll
    for (int j = 0; j < 16; ++j) { S0[j] = 0.f; S1[j] = 0.f; QH[j] = 0.f; }
    {
      const float dec = sc[0];
#pragma unroll
      for (int j = 0; j < 16; ++j) { Hacc[j] *= dec; }
      bf16x8 fa[2], fb0[2], fb1[2], fhb[2], fka[2], fvb[2];
      fa[0] = ldfrag(lds + MX_Q, 32 * rb, 0, lane); fb0[0] = ldfrag(lds + MX_K, 64 * cb, 0, lane); fb1[0] = ldfrag(lds + MX_K, 64 * cb + 32, 0, lane);
      fhb[0] = ldfrag(lds + MX_HT, 32 * cb, 0, lane); fka[0] = ldfrag(lds + MX_KT, 32 * rb, 0, lane); fvb[0] = ldfrag(lds + MX_VT, 32 * cb, 0, lane);
#pragma unroll
      for (int ks = 0; ks < 8; ++ks) {
        const int cur = ks & 1, nxt = cur ^ 1;
        if (ks < 7) {
          fa[nxt] = ldfrag(lds + MX_Q, 32 * rb, ks + 1, lane); fb0[nxt] = ldfrag(lds + MX_K, 64 * cb, ks + 1, lane); fb1[nxt] = ldfrag(lds + MX_K, 64 * cb + 32, ks + 1, lane);
          fhb[nxt] = ldfrag(lds + MX_HT, 32 * cb, ks + 1, lane); fka[nxt] = ldfrag(lds + MX_KT, 32 * rb, ks + 1, lane); fvb[nxt] = ldfrag(lds + MX_VT, 32 * cb, ks + 1, lane);
        }
        __builtin_amdgcn_sched_barrier(0);
        S0 = __builtin_amdgcn_mfma_f32_32x32x16_bf16(fa[cur], fb0[cur], S0, 0, 0, 0);
        S1 = __builtin_amdgcn_mfma_f32_32x32x16_bf16(fa[cur], fb1[cur], S1, 0, 0, 0);
        QH = __builtin_amdgcn_mfma_f32_32x32x16_bf16(fa[cur], fhb[cur], QH, 0, 0, 0);
        Hacc = __builtin_amdgcn_mfma_f32_32x32x16_bf16(fka[cur], fvb[cur], Hacc, 0, 0, 0);
        __builtin_amdgcn_sched_barrier(0);
      }
    }
    __syncthreads();
    { const int cn = c + 1 < nc ? c + 1 : c; MX_ISSUE_LOADS(dir ? nc - 1 - cn : cn); }
    {
      const int sA = 64 * cb + (lane & 31), sB = sA + 32;
      const float cA = vC[sA], cB = vC[sB];
      float mu16[16];
#pragma unroll
      for (int j = 0; j < 16; ++j) mu16[j] = vMu[32 * rb + 8 * (j >> 2) + 4 * (lane >> 5) + (j & 3)];
      __builtin_amdgcn_sched_barrier(0);
#pragma unroll
      for (int j = 0; j < 16; ++j) {
        const int t = 32 * rb + 8 * (j >> 2) + 4 * (lane >> 5) + (j & 3);
        const float mu = mu16[j];
        bool okA, okB;
        if (dir == 0) { okA = sA <= t; okB = sB <= t; } else if (BR == 2) { okA = sA > t; okB = sB > t; } else { okA = sA >= t; okB = sB >= t; }
        const float pa = okA ? S0[j] * __expf(cA - mu) : 0.f, pb = okB ? S1[j] * __expf(cB - mu) : 0.f;
        *(LAS bf16_t*)(lds + MX_Q + swz(t, sA)) = f2bf(pa);
        *(LAS bf16_t*)(lds + MX_Q + swz(t, sB)) = f2bf(pb);
      }
#pragma unroll
      for (int g4 = 0; g4 < 4; ++g4) {
        const int dk0 = 32 * rb + 8 * g4 + 4 * (lane >> 5), dvr = 32 * cb + (lane & 31);
        u32x2 w; w.x = cvt_pk_bf16(Hacc[4 * g4 + 0], Hacc[4 * g4 + 1]); w.y = cvt_pk_bf16(Hacc[4 * g4 + 2], Hacc[4 * g4 + 3]);
        *(LAS u32x2*)(lds + MX_HT + swz(dvr, dk0)) = w;
      }
    }
    __syncthreads();
    {
      float rsc[16];
#pragma unroll
      for (int j = 0; j < 16; ++j) { const int t = 32 * rb + 8 * (j >> 2) + 4 * (lane >> 5) + (j & 3); rsc[j] = vR[t]; QH[j] *= rsc[j]; }
      bf16x8 pa[2], pv[2];
      pa[0] = ldfrag(lds + MX_Q, 32 * rb, 0, lane); pv[0] = ldfrag(lds + MX_VT, 32 * cb, 0, lane);
#pragma unroll
      for (int ks = 0; ks < 8; ++ks) {
        const int cur = ks & 1, nxt = cur ^ 1;
        if (ks < 7) { pa[nxt] = ldfrag(lds + MX_Q, 32 * rb, ks + 1, lane); pv[nxt] = ldfrag(lds + MX_VT, 32 * cb, ks + 1, lane); }
        __builtin_amdgcn_sched_barrier(0);
        QH = __builtin_amdgcn_mfma_f32_32x32x16_bf16(pa[cur], pv[cur], QH, 0, 0, 0);
        __builtin_amdgcn_sched_barrier(0);
      }
#pragma unroll
      for (int j = 0; j < 16; ++j) {
        const int t = 32 * rb + 8 * (j >> 2) + 4 * (lane >> 5) + (j & 3);
        const float y = QH[j];
        if (DEN) { if (cb == 0 && (lane & 31) == 0) { float* dp = (float*)(p.ws + WS_DEN) + (((size_t)(dir * 4 + hd) * T) + tok0 + t) * 2; dp[0] = y; dp[1] = vCl[t]; } }
        else yout[(size_t)(tok0 + t) * 3072 + ocol + 32 * cb + (lane & 31)] = f2bf(y);
      }
    }
    __syncthreads();
  }
}

#undef MX_ISSUE_LOADS
__device__ void phase_mixer(const Params& p, LAS unsigned char* lds, int layer, int S, int conv_layer, int conv_parity) {
  const int nseq = T / S, nitems = nseq * 2 * 52;
  for (int it = blockIdx.x; it < nitems; it += gridDim.x) {
    const int ht_ord = it / (nseq * 2), rem = it % (nseq * 2), seq = rem >> 1, dir = rem & 1;
#ifdef ONLY_BR
    mixer_item<ONLY_BR, false>(p, lds, layer, S, seq, dir, ht_ord & 15);
#else
    if (ht_ord < 16) mixer_item<1, false>(p, lds, layer, S, seq, dir, ht_ord);
    else if (ht_ord < 20) mixer_item<1, true>(p, lds, layer, S, seq, dir, ht_ord - 16);
    else if (ht_ord < 36) mixer_item<2, false>(p, lds, layer, S, seq, dir, ht_ord - 20);
    else mixer_item<0, false>(p, lds, layer, S, seq, dir, ht_ord - 36);
#endif
  }
  if (conv_layer >= 0) {
    const int G = gridDim.x, rem = nitems % G, nconv = G - rem;
    if ((int)blockIdx.x >= rem) phase_convert(p, conv_layer, lds, conv_parity, (int)blockIdx.x - rem, nconv);
  }
}

__device__ void phase_post(const Params& p, int layer) {
  const int tid_ = opaque_tid(); const int lane = tid_ & 63, wid = tid_ >> 6;
  const bf16_t* proj = (const bf16_t*)(p.ws + WS_PROJ); const bf16_t* xc = (const bf16_t*)(p.ws + WS_XC);
  const bf16_t* yf = (const bf16_t*)(p.ws + WS_YF); const bf16_t* yb = (const bf16_t*)(p.ws + WS_YB);
  const float* den = (const float*)(p.ws + WS_DEN);
  bf16_t* act = (bf16_t*)(p.ws + WS_PROJ) + ACT_COL;
  const float* dsk = p.in[10] + layer * 16; const float* g_ssd = p.in[11] + layer * 1024; const float* g_ml = p.in[13] + layer * 1024; const float* g_rt = p.in[14] + layer * 1024;
  for (int row = blockIdx.x * 8 + wid; row < T; row += gridDim.x * 8) {
    u32x4 wf[3][2], wb[3][2], wg[3][2], wx[2]; float dn[2][4];
#pragma unroll
    for (int br = 0; br < 3; ++br)
#pragma unroll
      for (int k = 0; k < 2; ++k) {
        const int c = br * 1024 + k * 512 + lane * 8;
        wf[br][k] = *(const u32x4*)(yf + (size_t)row * 3072 + c); wb[br][k] = *(const u32x4*)(yb + (size_t)row * 3072 + c);
        const int gcol = (br == 0 ? C_Z : (br == 1 ? C_MLO : C_RTG)) + k * 512 + lane * 8;
        wg[br][k] = *(const u32x4*)(proj + (size_t)row * PLD + gcol);
      }
#pragma unroll
    for (int k = 0; k < 2; ++k) {
      wx[k] = *(const u32x4*)(xc + (size_t)row * 1536 + k * 512 + lane * 8);
      const int h = k * 2 + (lane >> 5);
      const float* df = den + (((size_t)(0 * 4 + h) * T) + row) * 2; const float* db = den + (((size_t)(1 * 4 + h) * T) + row) * 2;
      dn[k][0] = df[0]; dn[k][1] = df[1]; dn[k][2] = db[0]; dn[k][3] = db[1];
    }
#pragma unroll
    for (int br = 0; br < 3; ++br) {
      float y[2][8], gt[2][8], sq[2];
#pragma unroll
      for (int k = 0; k < 2; ++k) {
        const unsigned aa[4] = {wf[br][k].x, wf[br][k].y, wf[br][k].z, wf[br][k].w}, bb[4] = {wb[br][k].x, wb[br][k].y, wb[br][k].z, wb[br][k].w}, gg[4] = {wg[br][k].x, wg[br][k].y, wg[br][k].z, wg[br][k].w};
        float nf = 1.f, nb = 1.f;
        if (br == 1) { nf = 1.0f / fmaxf(fabsf(dn[k][0]), dn[k][1]); nb = 1.0f / fmaxf(fabsf(dn[k][2]), dn[k][3]); }
#pragma unroll
        for (int w = 0; w < 4; ++w) {
          y[k][2 * w] = bflo(aa[w]) * nf + bflo(bb[w]) * nb; y[k][2 * w + 1] = bfhi(aa[w]) * nf + bfhi(bb[w]) * nb;
          gt[k][2 * w] = bflo(gg[w]); gt[k][2 * w + 1] = bfhi(gg[w]);
        }
        if (br == 0) {
          const float dd = dsk[k * 8 + (lane >> 3)];
          const unsigned xx[4] = {wx[k].x, wx[k].y, wx[k].z, wx[k].w};
#pragma unroll
          for (int w = 0; w < 4; ++w) { y[k][2 * w] += bflo(xx[w]) * dd; y[k][2 * w + 1] += bfhi(xx[w]) * dd; }
#pragma unroll
          for (int e = 0; e < 8; ++e) y[k][e] *= siluf_(gt[k][e]);
        }
        float q = 0.f;
#pragma unroll
        for (int e = 0; e < 8; ++e) q += y[k][e] * y[k][e];
        q += __shfl_xor(q, 1); q += __shfl_xor(q, 2); q += __shfl_xor(q, 4); q += __shfl_xor(q, 8); q += __shfl_xor(q, 16);
        sq[k] = q;
      }
      float rs[2];
      if (br == 0) { float t = sq[0] + sq[1]; t += __shfl_xor(t, 32); rs[0] = rs[1] = rsqrtf(t * (1.0f / 1024.0f) + EPS); }
      else { rs[0] = rsqrtf(sq[0] * (1.0f / 256.0f) + EPS); rs[1] = rsqrtf(sq[1] * (1.0f / 256.0f) + EPS); }
#pragma unroll
      for (int k = 0; k < 2; ++k) {
        const float* gn = (br == 0 ? g_ssd : (br == 1 ? g_ml : g_rt)) + k * 512 + lane * 8;
        const f32x4 g0 = *(const f32x4*)gn, g1 = *(const f32x4*)(gn + 4);
        unsigned o[4];
#pragma unroll
        for (int e = 0; e < 8; e += 2) {
          float v0 = y[k][e] * rs[k] * (e < 4 ? g0[e] : g1[e - 4]), v1 = y[k][e + 1] * rs[k] * (e < 4 ? g0[e + 1] : g1[e - 3]);
          if (br == 1) { v0 *= sigmoidf_(gt[k][e]); v1 *= sigmoidf_(gt[k][e + 1]); }
          if (br == 2) { v0 *= siluf_(gt[k][e]); v1 *= siluf_(gt[k][e + 1]); }
          o[e >> 1] = cvt_pk_bf16(v0, v1);
        }
        *(u32x4*)(act + (size_t)row * PLD + br * 1024 + k * 512 + lane * 8) = (u32x4){o[0], o[1], o[2], o[3]};
      }
    }
  }
}

#ifndef PH_MASK
#define PH_MASK 0xFFFF
#endif
#ifndef REP_SYNC
#define REP_SYNC 1
#endif
#ifndef REP_MIX
#define REP_MIX 1
#endif
#ifndef REP_G1
#define REP_G1 1
#endif
#ifndef REP_MISC
#define REP_MISC 1
#endif
#ifndef REP_G2
#define REP_G2 1
#endif
#ifndef REP_G4
#define REP_G4 1
#endif
#define XB_TMO      128
#define XB_XCNT(j)  (256  + 64 * (j))
#define XB_XSUB(j)  (1280 + 64 * (j))
#define XB_XGEN(j)  (2304 + 64 * (j))
#define XB_TOP      3328
#define XB_TOPGEN   3392
#define XCD_BAR_WORDS 3456
#define XB_SPIN_CAP (1u << 22)

__device__ __forceinline__ unsigned xb_ld(unsigned* p)              { return __hip_atomic_load(p, __ATOMIC_RELAXED, __HIP_MEMORY_SCOPE_AGENT); }
__device__ __forceinline__ unsigned xb_add(unsigned* p, unsigned v) { return __hip_atomic_fetch_add(p, v, __ATOMIC_RELAXED, __HIP_MEMORY_SCOPE_AGENT); }
__device__ __forceinline__ unsigned xb_xcc_id() { return (unsigned)__builtin_amdgcn_s_getreg((3 << 11) | 20) & 0xFu; }
#define XB_SPIN(cond, bar) do { unsigned _sp = 0; while (cond) { __builtin_amdgcn_s_sleep(1); \
    if ((++_sp & 255u) == 0u) { if (xb_ld(&(bar)[XB_TMO])) break; if (_sp > XB_SPIN_CAP) { atomicAdd(&(bar)[XB_TMO], 1u); break; } } } } while (0)
struct XcdBarrier { unsigned* bar; unsigned x; volatile LAS unsigned* st; };
__device__ __forceinline__ XcdBarrier xcd_barrier_post(unsigned* bar, volatile LAS unsigned* st) {
    XcdBarrier b; b.bar = bar; b.x = xb_xcc_id(); b.st = st;
    if (threadIdx.x == 0) (void)xb_add(&bar[XB_XCNT(b.x)], 1u);
    return b;
}
__device__ __forceinline__ void xcd_barrier_complete(unsigned* bar, unsigned x, unsigned& nloc, unsigned& nx) {
    const unsigned G = gridDim.x * gridDim.y * gridDim.z;
    unsigned sum, cnt, mine, sp = 0u;
    for (;;) {
        sum = 0u; cnt = 0u; mine = 0u;
#pragma unroll
        for (unsigned j = 0; j < 16; ++j) { const unsigned c = xb_ld(&bar[XB_XCNT(j)]); sum += c; cnt += (c > 0u) ? 1u : 0u; mine = (j == x) ? c : mine; }
        if (sum == G) break;
        __builtin_amdgcn_s_sleep(1);
        if ((++sp & 255u) == 0u) { if (xb_ld(&bar[XB_TMO])) break; if (sp > XB_SPIN_CAP) { atomicAdd(&bar[XB_TMO], 1u); break; } }
    }
    nloc = mine > 0u ? mine : 1u; nx = cnt > 0u ? cnt : 1u;
}
__device__ __forceinline__ void xcd_barrier(const XcdBarrier& b) {
    asm volatile("s_waitcnt vmcnt(0)" ::: "memory");
    __syncthreads();
    if (threadIdx.x == 0) {
        unsigned* bar = b.bar;
        __builtin_amdgcn_s_waitcnt(0);
        unsigned nloc = b.st[0], nx = b.st[1];
        if (nloc == 0u) { xcd_barrier_complete(bar, b.x, nloc, nx); b.st[0] = nloc; b.st[1] = nx; }
        const unsigned old = xb_add(&bar[XB_XSUB(b.x)], 1u);
        const unsigned gen = old / nloc;
        if (old + 1u == (gen + 1u) * nloc) {
            __builtin_amdgcn_fence(__ATOMIC_RELEASE, "agent");
            asm volatile("s_waitcnt vmcnt(0)" ::: "memory");
            const unsigned og = xb_add(&bar[XB_TOP], 1u);
            const unsigned tg = og / nx;
            if (og + 1u == (tg + 1u) * nx) xb_add(&bar[XB_TOPGEN], 1u);
            else XB_SPIN(xb_ld(&bar[XB_TOPGEN]) == tg, bar);
            __builtin_amdgcn_fence(__ATOMIC_ACQUIRE, "agent");
            xb_add(&bar[XB_XGEN(b.x)], 1u);
            asm volatile("s_waitcnt vmcnt(0)" ::: "memory");
        } else {
            XB_SPIN(xb_ld(&bar[XB_XGEN(b.x)]) == gen, bar);
            __builtin_amdgcn_fence(__ATOMIC_ACQUIRE, "agent");
            asm volatile("s_waitcnt vmcnt(0)" ::: "memory");
        }
    }
    __syncthreads();
}
#define GSYNC() do { for (int r_ = 0; r_ < REP_SYNC; ++r_) { XcdBarrier xb_; xb_.bar = (unsigned*)(p.ws + WS_BAR); xb_.x = xb_xcc_id(); xb_.st = (volatile LAS unsigned*)(lds + LDS_XB); xcd_barrier(xb_); } } while (0)
__global__ void __launch_bounds__(512, 2) fwd_megakernel(Params p) {
  extern __shared__ __attribute__((aligned(16))) unsigned char smem[];
  LAS unsigned char* lds = (LAS unsigned char*)smem;
  cg::grid_group grid = cg::this_grid();
  if (threadIdx.x < 4) ((LAS unsigned*)(lds + LDS_XB))[threadIdx.x] = 0u;
  __syncthreads();
  (void)xcd_barrier_post((unsigned*)(p.ws + WS_BAR), (volatile LAS unsigned*)(lds + LDS_XB));
  grid.sync();
  const int G = gridDim.x, bid = blockIdx.x;
#define WSP(T_, off) ((T_*)(p.ws + (off)))
  for (int pl = 0; pl < 12; ++pl) {
    int pass = pl >> 2, layer = pl & 3;
    asm volatile("" : "+s"(pass), "+s"(layer));
    const int S = pass == 0 ? 4096 : 8192;
    {
      if (pl == 0) phase_convert(p, 0, lds, 0, (int)blockIdx.x, (int)gridDim.x);
      unsigned char* wcur = p.ws + ((pl & 1) ? WS_WB : 0);
      if (layer == 0) {
        if ((PH_MASK & 2) && pass > 0) phase_final_norm(WSP(bf16_t, WS_XB), p.out + (size_t)(pass - 1) * T * 1024, WSP(float, WS_SSQ), p.in[21]);
        GSYNC();
        if (PH_MASK & 2) phase_load_rows(pass == 0 ? p.in[0] : p.in[1] + (size_t)(pass - 1) * T * 1024, WSP(bf16_t, WS_XB), WSP(float, WS_SSQ));
      }
      GSYNC();
      for (int r_ = 0; r_ < REP_G1; ++r_) if (PH_MASK & 4) { pg8::Gemm g{WSP(bf16_t, WS_XB), (bf16_t*)(wcur + WS_W1), T, PLD, 1024, 1024, 1 << 20, 0}; pg8::StaticOrder so; so.init(T, PLD, G, bid); EpiProj E{WSP(bf16_t, WS_PROJ), WSP(float, WS_GS), WSP(float, WS_SSQ), S - 1}; pg8::gemm_phase(lds, g, so, E); }
      GSYNC();
      for (int r_ = 0; r_ < REP_MISC; ++r_) if (PH_MASK & 8) phase_conv(WSP(bf16_t, WS_PROJ), WSP(bf16_t, WS_XC), p.in[6] + layer * 4 * 1536, p.in[7] + layer * 1536, S);
      GSYNC();
      for (int r_ = 0; r_ < REP_MIX; ++r_) if (PH_MASK & 16) phase_mixer(p, lds, layer, S, pl < 11 ? ((pl + 1) & 3) : -1, (pl + 1) & 1);
      GSYNC();
      for (int ph_ = 0; ph_ < 2; ++ph_) {
        if (((ph_ ^ (bid >> 3)) & 1) != 0) { for (int r_ = 0; r_ < REP_MISC; ++r_) if (PH_MASK & 32) phase_post(p, layer); }
        else { for (int r2_ = 0; r2_ < REP_G2; ++r2_) if (PH_MASK & 64) { pg8::Gemm g{WSP(bf16_t, WS_XB), (bf16_t*)(wcur + WS_WG), T, 3072, 1024, 1024, 1 << 20, 0}; pg8::StaticOrder so; so.init(T, 3072, G, bid); EpiGate E{WSP(bf16_t, WS_GATE), p.in[5] + layer * 3072, WSP(float, WS_SSQ)}; pg8::gemm_phase(lds, g, so, E); } }
      }
      GSYNC();
      if (PH_MASK & 128) { pg8::Gemm g{WSP(bf16_t, WS_PROJ) + ACT_COL, (bf16_t*)(wcur + WS_W2), T, 3072, 1024, PLD, 4, 1024}; pg8::BranchOrder so; so.init(T, G, bid); EpiBranch E{WSP(bf16_t, WS_GATE), WSP(bf16_t, WS_GATED)}; pg8::gemm_phase(lds, g, so, E); }
      GSYNC();
      if (PH_MASK & 256) { pg8::Gemm g{WSP(bf16_t, WS_GATED), (bf16_t*)(wcur + WS_W3), T, 1024, 1024, 1024, 1 << 20, 0}; pg8::StaticOrder so; so.init(T, 1024, G, bid); EpiRes E{WSP(bf16_t, WS_XB), WSP(float, WS_SSQ)}; pg8::gemm_phase(lds, g, so, E); }
      GSYNC();
      for (int r4_ = 0; r4_ < REP_G4; ++r4_) if (PH_MASK & 512) { pg8::Gemm g{WSP(bf16_t, WS_XB), (bf16_t*)(wcur + WS_W4), T, 5632, 1024, 1024, 1 << 20, 0}; pg8::StaticOrder so; so.init(T, 5632, G, bid); EpiFfn E{WSP(bf16_t, WS_HID), WSP(float, WS_SSQ)}; pg8::gemm_phase(lds, g, so, E); }
      GSYNC();
      if (PH_MASK & 1024) { pg8::Gemm g{WSP(bf16_t, WS_HID), (bf16_t*)(wcur + WS_W5), T, 1024, FF, FF, 1 << 20, 0}; pg8::StaticOrder so; so.init(T, 1024, G, bid); EpiRes E{WSP(bf16_t, WS_XB), WSP(float, WS_SSQ)}; pg8::gemm_phase(lds, g, so, E); }
      GSYNC();
    }
  }
  phase_final_norm(WSP(bf16_t, WS_XB), p.out + (size_t)2 * T * 1024, WSP(float, WS_SSQ), p.in[21]);
}

extern "C" void kernel_launch(void* const* d_in, const int* in_sizes, int n_in, void* d_out, int out_size, void* d_ws, size_t ws_size, hipStream_t stream) {
  static int grid_blocks = 0;
  if (!grid_blocks) {
    int dev = 0, cus = 0, per_cu = 0;
    (void)hipGetDevice(&dev);
    (void)hipDeviceGetAttribute(&cus, hipDeviceAttributeMultiprocessorCount, dev);
    if (hipFuncSetAttribute((const void*)fwd_megakernel, hipFuncAttributeMaxDynamicSharedMemorySize, LDS_BYTES) != hipSuccess) fprintf(stderr, "hipFuncSetAttribute failed\n");
    if (hipOccupancyMaxActiveBlocksPerMultiprocessor(&per_cu, (const void*)fwd_megakernel, 512, LDS_BYTES) != hipSuccess || per_cu < 1) { fprintf(stderr, "occupancy query: %d\n", per_cu); per_cu = 1; }
    (void)hipGetLastError();
    grid_blocks = cus * per_cu;
    if (ws_size < WS_TOTAL || n_in != 22) { fprintf(stderr, "kernel_launch: workspace %zu < %zu or n_in %d\n", ws_size, (size_t)WS_TOTAL, n_in); }
  }
  Params p{};
  for (int i = 0; i < 22; ++i) p.in[i] = (const float*)d_in[i];
  p.out = (float*)d_out; p.ws = (unsigned char*)d_ws;
  (void)hipMemsetAsync((unsigned char*)d_ws + WS_BAR, 0, XCD_BAR_WORDS * 4, stream);
  void* args[] = {&p};
  hipError_t e = hipLaunchCooperativeKernel((const void*)fwd_megakernel, dim3(grid_blocks), dim3(512), args, LDS_BYTES, stream);
  if (e != hipSuccess) fprintf(stderr, "cooperative launch failed: %s (grid %d)\n", hipGetErrorString(e), grid_blocks);
}
```
